# Optimizing an MI355X kernel written in HIP

```python
import math
import jax, jax.numpy as jnp
from jax import lax
import numpy as np

D_MODEL = 1024
BATCH = 8
SEQ = 4096
DEPTH = 1

CHUNK = 64
Q_BLOCK = 128
SB_HEADS = 8
SB_HEAD_DIM = 64
SB_WIDTH = SB_HEADS * SB_HEAD_DIM
HG_HEADS = 4
HG_HEAD_DIM = 128
HG_WIDTH = HG_HEADS * HG_HEAD_DIM
N_BRANCHES = 2
IN_COLS = 3 * SB_WIDTH + 4 * HG_WIDTH + N_BRANCHES * D_MODEL
N_EXPERTS = 64
TOP_K = 8
N_GROUPS = 8
TOPK_GROUPS = 4
EXPERT_DIM = 256
SHARED_DIM = 256
ROUTED_SCALE = 2.5
DISPATCH_BLOCK = 256
N_MOD = 6
EPS = 1e-6

kernel_name = 'chunk_causal_sb_hgrn2_moe_block'


def rms_norm(x, g):
    xf = x.astype(jnp.float32)
    y = xf * lax.rsqrt(jnp.mean(xf * xf, axis=-1, keepdims=True) + EPS)
    return (y * g.astype(jnp.float32)).astype(x.dtype)


def swiglu(h, w_gate, w_up, w_down):
    return (jax.nn.silu(h @ w_gate) * (h @ w_up)) @ w_down


def stick_breaking_attention(q, k, v):
    B, H, S, dh = q.shape
    scale = dh ** -0.5
    outs = []
    for blk in range(S // Q_BLOCK):
        q0 = blk * Q_BLOCK
        k_end = q0 + Q_BLOCK
        qb = q[:, :, q0:k_end].astype(jnp.float32)
        kb = k[:, :, :k_end].astype(jnp.float32)
        vb = v[:, :, :k_end].astype(jnp.float32)
        z = jnp.einsum('bhqd,bhkd->bhqk', qb, kb) * scale
        t_pos = q0 + jnp.arange(Q_BLOCK)[:, None]
        s_pos = jnp.arange(k_end)[None, :]
        strict = s_pos < t_pos
        log_beta = jax.nn.log_sigmoid(z)
        log_keep = jnp.where(strict, log_beta - z, 0.0)
        after = lax.cumsum(log_keep, axis=3, reverse=True) - log_keep
        a = jnp.where(strict, jnp.exp(log_beta + after), 0.0)
        outs.append(jnp.einsum('bhqk,bhkd->bhqd', a, vb))
    return jnp.concatenate(outs, axis=2).astype(v.dtype)


def hgrn2_chunkwise(q, f_logits, i, gate, lb, norm_g):
    B, H, S, dk = q.shape
    dv = i.shape[-1]
    n = S // CHUNK
    f32 = jnp.float32
    lbb = lb.astype(f32)[None, :, None, :]
    forget = lbb + (1.0 - lbb) * jax.nn.sigmoid(f_logits.astype(f32))
    chunks = lambda t: t.reshape(B, H, n, CHUNK, t.shape[-1])
    qc = chunks(jax.nn.silu(q.astype(f32)))
    kc = chunks(1.0 - forget)
    vc = chunks(i.astype(f32))
    gc = jnp.cumsum(chunks(jnp.log(forget)), axis=3)
    g_ref = gc[:, :, :, CHUNK // 2 - 1:CHUNK // 2]
    causal = jnp.tril(jnp.ones((CHUNK, CHUNK), bool))
    scores = jnp.einsum('bhncd,bhnsd->bhncs', qc * jnp.exp(gc - g_ref), kc * jnp.exp(g_ref - gc))
    o_intra = jnp.einsum('bhncs,bhnsv->bhncv', jnp.where(causal, scores, 0.0), vc)
    g_last = gc[:, :, :, -1]
    chunk_kv = jnp.einsum('bhncd,bhncv->bhndv', kc * jnp.exp(g_last[:, :, :, None] - gc), vc)

    def carry_state(state, inp):
        decay, kv = inp
        return decay[..., None] * state + kv, state

    _, s_prev = lax.scan(carry_state, jnp.zeros((B, H, dk, dv), f32),
                         (jnp.moveaxis(jnp.exp(g_last), 2, 0), jnp.moveaxis(chunk_kv, 2, 0)))
    s_prev = jnp.moveaxis(s_prev, 0, 2)
    o_inter = jnp.einsum('bhncd,bhndv->bhncv', qc * jnp.exp(gc), s_prev)
    o = (o_intra + o_inter).reshape(B, H, S, dv)
    o = rms_norm(o, norm_g) * jax.nn.silu(gate.astype(f32))
    return o.astype(i.dtype)


def routed_experts(h, w_router, router_bias, w_gate, w_up, w_down):
    T, D = h.shape
    scores = jax.nn.sigmoid(h.astype(jnp.float32) @ w_router.astype(jnp.float32))
    choice = scores + router_bias.astype(jnp.float32)
    grouped = choice.reshape(T, N_GROUPS, N_EXPERTS // N_GROUPS)
    group_score = lax.top_k(grouped, 2)[0].sum(-1)
    _, top_groups = lax.top_k(group_score, TOPK_GROUPS)
    group_mask = jnp.zeros((T, N_GROUPS), bool).at[jnp.arange(T)[:, None], top_groups].set(True)
    expert_mask = jnp.repeat(group_mask, N_EXPERTS // N_GROUPS, axis=1)
    _, idx = lax.top_k(jnp.where(expert_mask, choice, -jnp.inf), TOP_K)
    sel = jnp.take_along_axis(scores, idx, axis=1)
    gates = sel / jnp.sum(sel, axis=1, keepdims=True) * ROUTED_SCALE

    n_assign = T * TOP_K
    flat_e = idx.reshape(-1).astype(jnp.int32)
    flat_tok = jnp.repeat(jnp.arange(T, dtype=jnp.int32), TOP_K)
    flat_w = gates.reshape(-1)
    order = jnp.argsort(flat_e)
    e_sorted = flat_e[order]
    counts = jnp.zeros((N_EXPERTS,), jnp.int32).at[flat_e].add(1)
    padded = (counts + DISPATCH_BLOCK - 1) // DISPATCH_BLOCK * DISPATCH_BLOCK
    pad_end = jnp.cumsum(padded)
    pad_start = pad_end - padded
    start = jnp.cumsum(counts) - counts
    rank = jnp.arange(n_assign, dtype=jnp.int32) - start[e_sorted]
    dest = pad_start[e_sorted] + rank
    n_slots = -(-(n_assign + N_EXPERTS * (DISPATCH_BLOCK - 1)) // DISPATCH_BLOCK) * DISPATCH_BLOCK
    n_blocks = n_slots // DISPATCH_BLOCK
    slot_tok = jnp.full((n_slots,), T, jnp.int32).at[dest].set(flat_tok[order])
    slot_w = jnp.zeros((n_slots,), jnp.float32).at[dest].set(flat_w[order])
    block_start = jnp.arange(n_blocks, dtype=jnp.int32) * DISPATCH_BLOCK
    block_expert = jnp.minimum(jnp.searchsorted(pad_end, block_start, side='right'), N_EXPERTS - 1)
    h_pad = jnp.concatenate([h, jnp.zeros((1, D), h.dtype)], axis=0)

    def expert_block(acc, inp):
        tok, w, e = inp
        rows = h_pad[tok]
        y = swiglu(rows, w_gate[e], w_up[e], w_down[e])
        return acc.at[tok].add((y * w[:, None].astype(y.dtype)).astype(acc.dtype)), None

    acc, _ = lax.scan(expert_block, jnp.zeros((T + 1, D), h.dtype),
                      (slot_tok.reshape(n_blocks, DISPATCH_BLOCK),
                       slot_w.reshape(n_blocks, DISPATCH_BLOCK), block_expert))
    return acc[:T]


def setup_inputs(seed: int = 0) -> dict:
    key = jax.random.key(seed)
    ks = jax.random.split(key, 22)
    f32 = jnp.float32
    L, D = DEPTH, D_MODEL

    def nrm(k, shape, scale):
        return jax.random.normal(k, shape, f32) * scale

    return {
        'x': nrm(ks[0], (BATCH, SEQ, D), 1.0),
        'c': nrm(ks[1], (BATCH, D), 1.0),
        'w_ada': nrm(ks[2], (L, D, N_MOD * D), 0.5 * D ** -0.5),
        'b_ada': nrm(ks[3], (L, N_MOD * D), 0.02),
        'norm1_g': 1.0 + nrm(ks[4], (L, D), 0.02),
        'w_in': nrm(ks[5], (L, D, IN_COLS), D ** -0.5),
        'sb_q_norm_g': 1.0 + nrm(ks[6], (L, SB_HEAD_DIM), 0.02),
        'sb_k_norm_g': 1.0 + nrm(ks[7], (L, SB_HEAD_DIM), 0.02),
        'hg_lb_logits': nrm(ks[8], (DEPTH + 1, HG_WIDTH), 0.1),
        'hg_norm_g': 1.0 + nrm(ks[9], (L, HG_HEAD_DIM), 0.02),
        'w_branch_sb': nrm(ks[10], (L, SB_WIDTH, D), SB_WIDTH ** -0.5),
        'w_branch_hg': nrm(ks[11], (L, HG_WIDTH, D), HG_WIDTH ** -0.5),
        'w_out': nrm(ks[12], (L, D, D), D ** -0.5),
        'norm2_g': 1.0 + nrm(ks[13], (L, D), 0.02),
        'w_router': nrm(ks[14], (L, D, N_EXPERTS), D ** -0.5),
        'router_bias': nrm(ks[15], (L, N_EXPERTS), 0.01),
        'w_e_gate': nrm(ks[16], (L, N_EXPERTS, D, EXPERT_DIM), D ** -0.5),
        'w_e_up': nrm(ks[17], (L, N_EXPERTS, D, EXPERT_DIM), D ** -0.5),
        'w_e_down': nrm(ks[18], (L, N_EXPERTS, EXPERT_DIM, D), EXPERT_DIM ** -0.5),
        'w_s_gate': nrm(ks[19], (L, D, SHARED_DIM), D ** -0.5),
        'w_s_up': nrm(ks[20], (L, D, SHARED_DIM), D ** -0.5),
        'w_s_down': nrm(ks[21], (L, SHARED_DIM, D), SHARED_DIM ** -0.5),
    }


def reference(x, c, w_ada, b_ada, norm1_g, w_in, sb_q_norm_g, sb_k_norm_g, hg_lb_logits,
              hg_norm_g, w_branch_sb, w_branch_hg, w_out, norm2_g, w_router, router_bias,
              w_e_gate, w_e_up, w_e_down, w_s_gate, w_s_up, w_s_down):
    B, S, D = x.shape
    cond = jax.nn.silu(c)
    lower_bounds = jnp.cumsum(jax.nn.softmax(hg_lb_logits.astype(jnp.float32), axis=0), axis=0)
    splits = list(np.cumsum([SB_WIDTH] * 3 + [HG_WIDTH] * 4 + [D_MODEL])[:])

    def heads(t, n):
        return t.reshape(B, S, n, -1).transpose(0, 2, 1, 3)

    for l in range(DEPTH):
        mod = cond @ w_ada[l] + b_ada[l]
        shift1, scale1, gate1, shift2, scale2, gate2 = jnp.split(mod[:, None, :], N_MOD, axis=-1)

        h = rms_norm(x, norm1_g[l]) * (1 + scale1) + shift1
        proj = h @ w_in[l]
        sb_q, sb_k, sb_v, hg_f, hg_i, hg_q, hg_g, g_sb, g_hg = jnp.split(proj, splits, axis=-1)

        q = rms_norm(heads(sb_q, SB_HEADS), sb_q_norm_g[l])
        k = rms_norm(heads(sb_k, SB_HEADS), sb_k_norm_g[l])
        o_sb = stick_breaking_attention(q, k, heads(sb_v, SB_HEADS))
        o_sb = o_sb.transpose(0, 2, 1, 3).reshape(B, S, SB_WIDTH)

        o_hg = hgrn2_chunkwise(heads(hg_q, HG_HEADS), heads(hg_f, HG_HEADS), heads(hg_i, HG_HEADS),
                               heads(hg_g, HG_HEADS),
                               lower_bounds[l].reshape(HG_HEADS, HG_HEAD_DIM), hg_norm_g[l])
        o_hg = o_hg.transpose(0, 2, 1, 3).reshape(B, S, HG_WIDTH)

        merged = (jax.nn.sigmoid(g_sb) * (o_sb @ w_branch_sb[l])
                  + jax.nn.sigmoid(g_hg) * (o_hg @ w_branch_hg[l]))
        x = x + gate1 * (merged @ w_out[l])

        h2 = (rms_norm(x, norm2_g[l]) * (1 + scale2) + shift2).reshape(B * S, D)
        ffn = (swiglu(h2, w_s_gate[l], w_s_up[l], w_s_down[l])
               + routed_experts(h2, w_router[l], router_bias[l], w_e_gate[l], w_e_up[l], w_e_down[l]))
        x = x + gate2 * ffn.reshape(B, S, D)
    return x
```

```cpp
#define MK_N_LAUNCHES 1
#define DBG_CHECK 0
#define REPEAT_MASK 0
#include <hip/hip_runtime.h>
#include <cstdio>
#include <cstdint>

#ifndef MK_N_LAUNCHES
#define MK_N_LAUNCHES 1
#endif
#ifndef DBG_CHECK
#define DBG_CHECK 0
#endif

#define GAS __attribute__((address_space(1)))
#define LAS __attribute__((address_space(3)))
typedef unsigned short bf16;
typedef unsigned v4u __attribute__((ext_vector_type(4)));
typedef unsigned v2u __attribute__((ext_vector_type(2)));
typedef float f32x4 __attribute__((ext_vector_type(4)));
typedef float f32x16 __attribute__((ext_vector_type(16)));
typedef float f32x2v __attribute__((ext_vector_type(2)));
typedef short bf16x8 __attribute__((ext_vector_type(8)));
typedef short s16x4 __attribute__((ext_vector_type(4)));
typedef int v4i_t __attribute__((ext_vector_type(4)));
typedef GAS unsigned gu32;
#define RLX_AGENT __ATOMIC_RELAXED, __HIP_MEMORY_SCOPE_AGENT
#define LDS_WAIT() asm volatile("s_waitcnt lgkmcnt(0)" ::: "memory")
#define VM_WAIT() asm volatile("s_waitcnt vmcnt(0)" ::: "memory")

__device__ __forceinline__ unsigned f2bf(float f) { unsigned u = __builtin_bit_cast(unsigned, f); return (u + 0x7fffu + ((u >> 16) & 1u)) >> 16; }
__device__ __forceinline__ unsigned pk2(float lo, float hi) { return f2bf(lo) | (f2bf(hi) << 16); }
__device__ __forceinline__ float bf2f(unsigned b) { return __builtin_bit_cast(float, b << 16); }
__device__ __forceinline__ float bflo(unsigned w) { return __builtin_bit_cast(float, w << 16); }
__device__ __forceinline__ float bfhi(unsigned w) { return __builtin_bit_cast(float, w & 0xffff0000u); }
__device__ __forceinline__ float fsigmoid(float x) { return __builtin_amdgcn_rcpf(1.0f + __expf(-x)); }
__device__ __forceinline__ float fsilu(float x) { return x * __builtin_amdgcn_rcpf(1.0f + __expf(-x)); }

__device__ __forceinline__ int fresh_lane() { int l; asm volatile("v_mbcnt_lo_u32_b32 %0, -1, 0\n\tv_mbcnt_hi_u32_b32 %0, -1, %0" : "=v"(l)); return l; }
__device__ __forceinline__ int fresh_tid(int wv) { return (wv << 6) | fresh_lane(); }

constexpr int NB = 8, SEQ = 4096, T = NB * SEQ, D = 1024;
constexpr int NA = 3584, NG = 2048, NIN = NA + NG;
constexpr int COL_Q = 0, COL_K = 512, COL_V = 1024, COL_F = 1536, COL_I = 2048, COL_HQ = 2560, COL_HG = 3072;
constexpr int NE = 64, EH = 256, NVE = 128;
constexpr float EPS = 1e-6f;
__device__ __forceinline__ size_t proj_at(size_t row, int col) { return ((row >> 4) * 56 + (size_t)(col >> 6)) * 1024 + (row & 15) * 64 + (col & 63); }

namespace pg8 {
#define PG8_LAS __attribute__((address_space(3)))
constexpr int BM = 256, BK = 64, HALF = 128, HTB = HALF * BK * 2, STAGE_BYTES = 8 * HTB, NXCD = 8, WGM = 4;
__host__ __device__ __forceinline__ int lds_byte(int r, int c) { const int st = (r >> 4) * 2 + (c >> 5), rr = r & 15, cc = c & 31, ob = rr * 64 + cc * 2; return st * 1024 + (ob ^ (((ob >> 9) & 1) << 5)); }
__host__ __device__ __forceinline__ void stage_rc(int b, int& R, int& C) { const int st = b / 1024, sb = b % 1024, swz = sb ^ (((sb >> 9) & 1) << 5); R = (st >> 1) * 16 + swz / 64; C = (st & 1) * 32 + (swz % 64) / 2; }
__host__ __device__ __forceinline__ int perm32(int rho) { const int n = rho >> 4, i = rho & 15; return 8 * (i >> 2) + 4 * n + (i & 3); }

struct Unit { int pm, pn, z, r0, nr, ar; };

struct DenseOrder {
    int nM, nN, nwg, G, c;
    __device__ void init(int M, int N, int G_, int c_) { nM = M / BM; nN = N / BM; nwg = nM * nN; G = G_; c = c_; }
    __device__ bool tile(int i, int& pm, int& pn) const {
        const long L = (long)i * G + c; if (L >= nwg) return false;
        int wgid = (int)L; { const int q = nwg / NXCD, r = nwg % NXCD, xcd = wgid % NXCD, off = wgid / NXCD; wgid = (xcd < r ? xcd * (q + 1) : r * (q + 1) + (xcd - r) * q) + off; }
        const int nig = WGM * nN, gid = wgid / nig, fm = gid * WGM, gsz = (nM - fm) < WGM ? (nM - fm) : WGM;
        pm = fm + ((wgid % nig) % gsz); pn = (wgid % nig) / gsz; return true;
    }
};

__device__ __forceinline__ unsigned cvt_pk_bf16(float lo, float hi) { unsigned r; asm volatile("v_cvt_pk_bf16_f32 %0, %1, %2" : "=v"(r) : "v"(lo), "v"(hi)); return r; }

template <class Epi, class Sched, bool GATHER, int K, int lda, int ldb, bool HOOK = false, bool FP8 = false>
__device__ __forceinline__ void gemm_phase(PG8_LAS unsigned char* lds, const Sched& S, const Epi& E, const int wv) {
    const int tid = fresh_tid(wv);
    const int wid = wv, lane = tid & 63, wr = wid >> 2, wc = wid & 3, fr = lane & 15, fq = lane >> 4;
    constexpr int nt = K / BK;
    unsigned voffA[2], voffB[2]; int RA[2], CA[2];
#pragma unroll
    for (int i = 0; i < 2; ++i) { int R, C; stage_rc(tid * 16 + i * 8192, R, C); const int Rb = Epi::PERM == 2 ? (64 * (R >> 5) + 16 * ((R >> 2) & 3) + 4 * ((R >> 4) & 1) + (R & 3)) : (Epi::PERM == 1 ? ((R & ~31) + perm32(R & 31)) : R);
        RA[i] = R; CA[i] = C; voffA[i] = (unsigned)(R * lda + C) * 2u; voffB[i] = (unsigned)(Rb * ldb + C) * 2u; }
    const size_t kstep = (size_t)(BK * 2);
    const size_t hstepA = (size_t)HALF * lda * 2, hstepB = (size_t)(Epi::PERM == 2 ? 8 : HALF) * ldb * 2;
    const unsigned ldsw = (unsigned)wid * 1024u;
    int aoff = lds_byte(wr * 64 + fr, fq * 8), boff = lds_byte(wc * 32 + fr, fq * 8);
#define PG8_SA(b, h) (((b) * 2 + (h)) * HTB)
#define PG8_SB(b, h) ((4 + (b) * 2 + (h)) * HTB)
#define PG8_STAGE(bufoff, gbase, voff) do { const char* _g = (const char*)(gbase); asm volatile("" : "+s"(_g));     \
        _Pragma("unroll") for (int _i = 0; _i < 2; ++_i) { unsigned _o = (voff)[_i]; asm volatile("" : "+v"(_o)); \
        __builtin_amdgcn_global_load_lds((const unsigned*)(_g + _o), (PG8_LAS unsigned*)(lds + (bufoff) + ldsw + _i * 8192), 16, 0, 0); } } while (0)
#define PG8_LDA(dst, b, h) do { _Pragma("unroll") for (int m = 0; m < 4; ++m) _Pragma("unroll") for (int k = 0; k < 2; ++k) dst[m][k] = *(const PG8_LAS bf16x8*)(lds + PG8_SA(b, h) + aoff + m * 2048 + k * 1024); } while (0)
#define PG8_LDB(dst, b, h) do { _Pragma("unroll") for (int n = 0; n < 2; ++n) _Pragma("unroll") for (int k = 0; k < 2; ++k) dst[n][k] = *(const PG8_LAS bf16x8*)(lds + PG8_SB(b, h) + boff + n * 2048 + k * 1024); } while (0)
#define PG8_CAT8(x) __builtin_shufflevector(__builtin_bit_cast(v4i_t, (x)[0]), __builtin_bit_cast(v4i_t, (x)[1]), 0, 1, 2, 3, 4, 5, 6, 7)
#define PG8_MMA(ai, bj, At, Bt) do { __builtin_amdgcn_s_setprio(1); \
        if constexpr (FP8) { _Pragma("unroll") for (int m = 0; m < 4; ++m) _Pragma("unroll") for (int n = 0; n < 2; ++n) \
            acc[ai][bj][m][n] = __builtin_amdgcn_mfma_scale_f32_16x16x128_f8f6f4(PG8_CAT8(Bt[n]), PG8_CAT8(At[m]), acc[ai][bj][m][n], 0, 0, 0, 0, 0, 0); } \
        else { _Pragma("unroll") for (int m = 0; m < 4; ++m) _Pragma("unroll") for (int n = 0; n < 2; ++n) _Pragma("unroll") for (int k = 0; k < 2; ++k) \
            acc[ai][bj][m][n] = __builtin_amdgcn_mfma_f32_16x16x32_bf16(Bt[n][k], At[m][k], acc[ai][bj][m][n], 0, 0, 0); } \
        __builtin_amdgcn_s_setprio(0); } while (0)
#define PG8_WAIT_V(n) asm volatile("s_waitcnt vmcnt(" #n ")" ::: "memory")
#define PG8_WAIT_L(n) asm volatile("s_waitcnt lgkmcnt(" #n ")" ::: "memory")
#define PG8_BAR __builtin_amdgcn_s_barrier()
#define PG8_SCHED __builtin_amdgcn_sched_barrier(0)
    Unit cur, nxt; int ui = 0;
    if (!S.next(0, cur)) return;
    f32x4 acc[2][2][4][2];
#pragma unroll
    for (int a = 0; a < 2; ++a)
#pragma unroll
        for (int b = 0; b < 2; ++b)
#pragma unroll
            for (int m = 0; m < 4; ++m)
#pragma unroll
                for (int n = 0; n < 2; ++n) acc[a][b][m][n] = (f32x4){0.f, 0.f, 0.f, 0.f};
    bf16x8 At[4][2], B0[2][2], B1[2][2];
    unsigned oc[2][2];
#pragma unroll
    for (int h = 0; h < 2; ++h)
#pragma unroll
        for (int i = 0; i < 2; ++i) oc[h][i] = GATHER ? (S.a_row(cur, RA[i] + h * HALF) * (unsigned)lda + (unsigned)CA[i]) * 2u : voffA[i];
#define PG8_OA(h) (GATHER ? oc[h] : voffA)
    const size_t hA = GATHER ? (size_t)0 : hstepA;
    const char* cA = S.a_base(cur); const char* cB = S.b_base(cur);
    PG8_STAGE(PG8_SB(0, 0), cB, voffB); PG8_STAGE(PG8_SB(0, 1), cB + hstepB, voffB); PG8_STAGE(PG8_SA(0, 0), cA, PG8_OA(0)); PG8_STAGE(PG8_SA(0, 1), cA + hA, PG8_OA(1));
    if (wr == 1) PG8_BAR;
    PG8_WAIT_V(2); PG8_BAR;
    PG8_STAGE(PG8_SB(1, 0), cB + kstep, voffB); PG8_STAGE(PG8_SA(1, 0), cA + kstep, PG8_OA(0)); PG8_STAGE(PG8_SB(1, 1), cB + hstepB + kstep, voffB);
    PG8_WAIT_V(6); PG8_BAR;
    for (;;) {
        const bool has_next = S.next(ui + 1, nxt);
        const char* nA = has_next ? S.a_base(nxt) : cA; const char* nB = has_next ? S.b_base(nxt) : cB;
        int ntv = nt; if constexpr (nt == 2) asm volatile("" : "+s"(ntv));
#pragma unroll 1
        for (int t = 0; t < ntv; t += 2) {
            const bool last = (t == ntv - 2);
            asm volatile("" : "+v"(aoff), "+v"(boff));
            if constexpr (HOOK) { if (t == nt / 2) { const int t3 = fresh_tid(wv);
                const int w3 = wv, l3 = t3 & 63; E.mid(acc, cur, w3 >> 2, w3 & 3, l3 & 15, l3 >> 4); } }
            const char* a1 = cA + (size_t)(t + 1) * kstep;
            const char* a2 = last ? nA : cA + (size_t)(t + 2) * kstep; const char* b2 = last ? nB : cB + (size_t)(t + 2) * kstep;
            const char* a3 = a2 + kstep; const char* b3 = b2 + kstep;
            PG8_LDB(B0, 0, 0); PG8_LDB(B1, 0, 1); PG8_SCHED; PG8_LDA(At, 0, 0); PG8_STAGE(PG8_SA(1, 1), a1 + hA, PG8_OA(1));
            if constexpr (GATHER) { if (last && has_next) { const int t4 = fresh_tid(wv);
#pragma unroll
                for (int i = 0; i < 2; ++i) { int R, C; stage_rc(t4 * 16 + i * 8192, R, C);
#pragma unroll
                    for (int h = 0; h < 2; ++h) oc[h][i] = (S.a_row(nxt, R + h * HALF) * (unsigned)lda + (unsigned)C) * 2u; } } }
            PG8_WAIT_V(8); PG8_WAIT_L(0); PG8_BAR; PG8_MMA(0, 0, At, B0); PG8_MMA(0, 1, At, B1); PG8_BAR; PG8_SCHED;
            PG8_LDA(At, 0, 1); PG8_STAGE(PG8_SB(0, 0), b2, voffB); PG8_STAGE(PG8_SB(0, 1), b2 + hstepB, voffB); PG8_STAGE(PG8_SA(0, 0), a2, PG8_OA(0));
            PG8_WAIT_V(8); PG8_WAIT_L(0); PG8_BAR; PG8_MMA(1, 0, At, B0); PG8_MMA(1, 1, At, B1); PG8_BAR; PG8_SCHED;
            PG8_LDB(B0, 1, 0); PG8_LDB(B1, 1, 1); PG8_SCHED; PG8_LDA(At, 1, 0); PG8_STAGE(PG8_SA(0, 1), a2 + hA, PG8_OA(1));
            PG8_WAIT_V(8); PG8_WAIT_L(0); PG8_BAR; PG8_MMA(0, 0, At, B0); PG8_MMA(0, 1, At, B1); PG8_BAR; PG8_SCHED;
            PG8_LDA(At, 1, 1); PG8_STAGE(PG8_SB(1, 0), b3, voffB); PG8_STAGE(PG8_SB(1, 1), b3 + hstepB, voffB); PG8_STAGE(PG8_SA(1, 0), a3, PG8_OA(0));
            PG8_WAIT_V(8); PG8_WAIT_L(0); PG8_BAR; PG8_MMA(1, 0, At, B0); PG8_MMA(1, 1, At, B1); PG8_BAR; PG8_SCHED;
        }
        if (wr == 0) PG8_BAR;
        { const int t2 = fresh_tid(wv);
          const int w2 = wv, l2 = t2 & 63; E(acc, cur, w2 >> 2, w2 & 3, l2 & 15, l2 >> 4); }
        if (!has_next) break;
#pragma unroll
        for (int a = 0; a < 2; ++a)
#pragma unroll
            for (int b = 0; b < 2; ++b)
#pragma unroll
                for (int m = 0; m < 4; ++m)
#pragma unroll
                    for (int n = 0; n < 2; ++n) acc[a][b][m][n] = (f32x4){0.f, 0.f, 0.f, 0.f};
        cur = nxt; cA = nA; cB = nB; ++ui;
        if (wr == 1) PG8_BAR;
    }
    PG8_WAIT_V(0);
    PG8_BAR;
#undef PG8_OA
#undef PG8_SA
#undef PG8_SB
#undef PG8_STAGE
#undef PG8_LDA
#undef PG8_LDB
#undef PG8_MMA
#undef PG8_CAT8
#undef PG8_WAIT_V
#undef PG8_WAIT_L
#undef PG8_BAR
#undef PG8_SCHED
}
}
constexpr size_t MiB = 1u << 20;
constexpr size_t WS_CTL = 0, CTL_ZERO_BYTES = 1 * MiB;
constexpr size_t WS_MOD = 1 * MiB;
constexpr size_t WS_WIN = 2 * MiB;
constexpr size_t WS_WBS = 13 * MiB, WS_WBH = 14 * MiB;
constexpr size_t WS_WO = 15 * MiB;
constexpr size_t WS_WGU = 18 * MiB;
constexpr size_t WS_WD = 83 * MiB;
constexpr size_t WS_PROJ = 116 * MiB;
constexpr size_t WS_GATES = 340 * MiB;
constexpr size_t WS_HGL = 468 * MiB;
constexpr size_t WS_HGG = 484 * MiB;
constexpr size_t WS_MERGED = 116 * MiB;
constexpr size_t WS_H2 = 180 * MiB;
constexpr size_t WS_ACT = 244 * MiB;
constexpr size_t WS_XMID = 324 * MiB;
constexpr size_t WS_LIST = 404 * MiB;
constexpr size_t WS_Y0 = 2 * MiB, WS_Y1 = 116 * MiB, WS_Y2 = 180 * MiB, WS_Y3 = 436 * MiB;
constexpr size_t WS_YS0 = 66 * MiB, WS_YS1 = 420 * MiB;
constexpr size_t WS_END = 512 * MiB;
constexpr int ACT_SHARED_ROW0 = 262144 + 128 * 255 + 1;
constexpr int ACT_SH0 = ((ACT_SHARED_ROW0 + 255) / 256) * 256;
static_assert((size_t)(ACT_SH0 + T) * 256 <= 80 * MiB, "act region");
constexpr int CW_FAIL = 2;
constexpr int CW_BAR = 4096;
constexpr int CW_CNT = 16384;
constexpr int RING_BYTES = 131072;
constexpr int LDSCTL_OFF = 143360, MISC_OFF = LDSCTL_OFF + 320;
constexpr int TAB_OFF = LDSCTL_OFF + 1024;
constexpr int EPI_STG_OFF = 147456;
constexpr int LDS_BYTES = 163840;

#define XB_TMO      128
#define XB_XCNT(j)  (256  + 64 * (j))
#define XB_XSUB(j)  (1280 + 64 * (j))
#define XB_XGEN(j)  (2304 + 64 * (j))
#define XB_TOP      3328
#define XB_TOPGEN   3392
#define XCD_BAR_WORDS 3456
#define XB_SPIN_CAP (1u << 18)
__device__ __forceinline__ unsigned xb_ld(unsigned* p)              { return __hip_atomic_load(p, __ATOMIC_RELAXED, __HIP_MEMORY_SCOPE_AGENT); }
__device__ __forceinline__ unsigned xb_add(unsigned* p, unsigned v) { return __hip_atomic_fetch_add(p, v, __ATOMIC_RELAXED, __HIP_MEMORY_SCOPE_AGENT); }
__device__ __forceinline__ unsigned xb_xcc_id() { return (unsigned)__builtin_amdgcn_s_getreg((3 << 11) | 20) & 0xFu; }
#define XB_SPIN(cond, bar) do { unsigned _sp = 0; while (cond) { __builtin_amdgcn_s_sleep(1); \
    if ((++_sp & 255u) == 0u) { if (xb_ld(&(bar)[XB_TMO])) break; if (_sp > XB_SPIN_CAP) { atomicAdd(&(bar)[XB_TMO], 1u); break; } } } } while (0)
struct XcdBarrier { unsigned* bar; unsigned x; volatile LAS unsigned* st; int wv; };
__device__ __forceinline__ XcdBarrier xcd_barrier_post(unsigned* bar, volatile LAS unsigned* st, int wv) {
    XcdBarrier b; b.bar = bar; b.x = xb_xcc_id(); b.st = st; b.wv = wv;
    if (wv == 0 && fresh_lane() == 0) (void)xb_add(&bar[XB_XCNT(b.x)], 1u);
    return b;
}
__device__ __forceinline__ void xcd_barrier_complete(unsigned* bar, unsigned x, unsigned& nloc, unsigned& nx) {
    const unsigned G = gridDim.x * gridDim.y * gridDim.z;
    unsigned sum, cnt, mine, sp = 0u;
    for (;;) {
        sum = 0u; cnt = 0u; mine = 0u;
#pragma unroll
        for (unsigned j = 0; j < 16; ++j) { const unsigned c = xb_ld(&bar[XB_XCNT(j)]); sum += c; cnt += (c > 0u) ? 1u : 0u; mine = (j == x) ? c : mine; }
        if (sum == G) break;
        __builtin_amdgcn_s_sleep(1);
        if ((++sp & 255u) == 0u) { if (xb_ld(&bar[XB_TMO])) break; if (sp > XB_SPIN_CAP) { atomicAdd(&bar[XB_TMO], 1u); break; } }
    }
    nloc = mine > 0u ? mine : 1u; nx = cnt > 0u ? cnt : 1u;
}
__device__ __forceinline__ void xcd_barrier(const XcdBarrier& b) {
    asm volatile("s_waitcnt vmcnt(0)" ::: "memory");
    __syncthreads();
    if (b.wv == 0 && fresh_lane() == 0) {
        unsigned* bar = b.bar;
        __builtin_amdgcn_s_waitcnt(0);
        unsigned nloc = b.st[0], nx = b.st[1];
        if (nloc == 0u) { xcd_barrier_complete(bar, b.x, nloc, nx); b.st[0] = nloc; b.st[1] = nx; }
        const unsigned old = xb_add(&bar[XB_XSUB(b.x)], 1u);
        const unsigned gen = old / nloc;
        if (old + 1u == (gen + 1u) * nloc) {
            __builtin_amdgcn_fence(__ATOMIC_RELEASE, "agent");
            asm volatile("s_waitcnt vmcnt(0)" ::: "memory");
            const unsigned og = xb_add(&bar[XB_TOP], 1u);
            const unsigned tg = og / nx;
            if (og + 1u == (tg + 1u) * nx) xb_add(&bar[XB_TOPGEN], 1u);
            else XB_SPIN(xb_ld(&bar[XB_TOPGEN]) == tg, bar);
            __builtin_amdgcn_fence(__ATOMIC_ACQUIRE, "agent");
            xb_add(&bar[XB_XGEN(b.x)], 1u);
            asm volatile("s_waitcnt vmcnt(0)" ::: "memory");
        } else {
            XB_SPIN(xb_ld(&bar[XB_XGEN(b.x)]) == gen, bar);
            __builtin_amdgcn_fence(__ATOMIC_ACQUIRE, "agent");
            asm volatile("s_waitcnt vmcnt(0)" ::: "memory");
        }
    }
    __syncthreads();
}

struct Args {
    const float *x, *c, *w_ada, *b_ada, *norm1_g, *w_in, *sb_q_g, *sb_k_g, *hg_lb, *hg_norm_g, *w_br_sb, *w_br_hg, *w_out, *norm2_g, *w_router, *router_bias,
                *w_e_gate, *w_e_up, *w_e_down, *w_s_gate, *w_s_up, *w_s_down;
    float* out; unsigned char* ws; int ph_lo, ph_hi;
};
struct Frame {
    LAS unsigned char* lds; volatile LAS unsigned* MISC; gu32* ctl;
    int tid, lane, wave, vcu, G;
};
__device__ __forceinline__ float wave_sum(float v) {
#pragma unroll
    for (int o = 1; o < 64; o <<= 1) v += __shfl_xor(v, o);
    return v;
}

__device__ __forceinline__ void p0a_mod(Frame& F, const Args& a) {
    LAS float* cond = (LAS float*)F.lds;
    LAS float* red = (LAS float*)(F.lds + 32768);
    for (int i = F.tid; i < NB * D; i += 512) cond[i] = fsilu(a.c[i]);
    __syncthreads();
    float* mod = (float*)(a.ws + WS_MOD);
    for (int cb = blockIdx.x; cb < 6144 / 24; cb += F.G) {
        float acc[8];
#pragma unroll
        for (int b = 0; b < 8; ++b) acc[b] = 0.f;
        const int col = F.lane % 24, ksub = F.lane / 24;
        if (F.lane < 48) {
            for (int i = 0; i < 64; ++i) { const int k = 128 * F.wave + 2 * i + ksub; const float w = a.w_ada[(size_t)k * 6144 + cb * 24 + col];
#pragma unroll
                for (int b = 0; b < 8; ++b) acc[b] += cond[b * D + k] * w; }
#pragma unroll
            for (int b = 0; b < 8; ++b) red[((F.wave * 2 + ksub) * 24 + col) * 8 + b] = acc[b];
        }
        __syncthreads();
        if (F.tid < 192) { const int c2 = F.tid >> 3, b = F.tid & 7; float s = 0.f;
            for (int p = 0; p < 16; ++p) s += red[(p * 24 + c2) * 8 + b];
            mod[b * 6144 + cb * 24 + c2] = s + a.b_ada[cb * 24 + c2]; }
        __syncthreads();
    }
}

__device__ __forceinline__ float fp8_clamp(float x) { return __builtin_amdgcn_fmed3f(x, -440.f, 440.f); }
__device__ __forceinline__ unsigned pk4_fp8(float a, float b, float c, float d) { int r = __builtin_amdgcn_cvt_pk_fp8_f32(fp8_clamp(a), fp8_clamp(b), 0, false); r = __builtin_amdgcn_cvt_pk_fp8_f32(fp8_clamp(c), fp8_clamp(d), r, true); return (unsigned)r; }
constexpr float WBS_SCALE = 16.f, WO_SCALE = 32.f;
constexpr float WIN_SCALE = 32.f;
constexpr float WGU_SCALE = 32.f;
constexpr float WD_SCALE = 16.f, ACT_SCALE = 16.f, Y_SCALE = 16.f;
__device__ __forceinline__ void p0_tr_load(float (&v)[32], const float* W, int N, int item, int lane) {
    const int nblk = N / 32, kb = item / nblk, nb = item % nblk, k0 = 64 * kb, n0 = 32 * nb;
    const float* p = W + (size_t)(k0 + (lane >> 5)) * N + n0 + (lane & 31);
#pragma unroll
    for (int i = 0; i < 32; ++i) v[i] = __builtin_nontemporal_load(p + (size_t)(2 * i) * N);
}
__device__ __forceinline__ void p0_tr_finish(const float (&v)[32], int K, int N, bf16* WT, int row_off, int mode, int is_up, LAS float* scr, int item, int lane, int ldk = 0, int koff = 0, float f8scale = 0.f) {
    if (ldk == 0) ldk = K;
    const int nblk = N / 32, kb = item / nblk, nb = item % nblk, k0 = 64 * kb, n0 = 32 * nb;
#pragma unroll
    for (int i = 0; i < 32; ++i) { const int kk = 2 * i + (lane >> 5); scr[kk * 33 + (lane & 31)] = v[i]; }
    LDS_WAIT(); asm volatile("" ::: "memory");
    const int c = lane & 7;
#pragma unroll
    for (int j = 0; j < 4; ++j) { const int n = (lane >> 3) + 8 * j; const LAS float* s = scr + (8 * c) * 33 + n;
        v4u o; o.x = pk2(s[0 * 33], s[1 * 33]); o.y = pk2(s[2 * 33], s[3 * 33]); o.z = pk2(s[4 * 33], s[5 * 33]); o.w = pk2(s[6 * 33], s[7 * 33]);
        const int ng = n0 + n; const int drow = mode ? (row_off + 256 * (ng >> 7) + (ng & 127) + 128 * is_up) : (row_off + ng);
        if (f8scale != 0.f) { v2u o8; o8.x = pk4_fp8(s[0 * 33] * f8scale, s[1 * 33] * f8scale, s[2 * 33] * f8scale, s[3 * 33] * f8scale); o8.y = pk4_fp8(s[4 * 33] * f8scale, s[5 * 33] * f8scale, s[6 * 33] * f8scale, s[7 * 33] * f8scale);
            *(GAS v2u*)((unsigned char*)WT + (size_t)drow * ldk + koff + k0 + 8 * c) = o8; }
        else *(GAS v4u*)(WT + (size_t)drow * ldk + koff + k0 + 8 * c) = o; }
    LDS_WAIT(); asm volatile("" ::: "memory");
}
__device__ __forceinline__ void p0_transpose_item(const float* W, int K, int N, bf16* WT, int row_off, int mode, int is_up, LAS float* scr, int item, int lane, int ldk = 0, int koff = 0, float f8scale = 0.f) {
    float v[32]; p0_tr_load(v, W, N, item, lane); p0_tr_finish(v, K, N, WT, row_off, mode, is_up, scr, item, lane, ldk, koff, f8scale);
}
__device__ __forceinline__ void convert_expert_weights(Frame& F, const Args& a, LAS unsigned char* scr_base) {
    LAS float* scr = (LAS float*)(scr_base + F.wave * 8448);
    const int gw = F.vcu * 8 + F.wave, NGW = F.G * 8;
    bf16* WguT = (bf16*)(a.ws + WS_WGU); bf16* WdT = (bf16*)(a.ws + WS_WD);
    constexpr int I_GU = 16 * 8, I_DN = 4 * 32, I_E = 2 * I_GU + I_DN, NIT = 65 * I_E;
#define CEW_SRC(it, W, N, r) const float* W; int N, r; { const int e_ = (it) / I_E; r = (it) - e_ * I_E; \
        if (r < I_GU) { W = e_ < 64 ? a.w_e_gate + (size_t)e_ * D * EH : a.w_s_gate; N = EH; } \
        else if (r < 2 * I_GU) { r -= I_GU; W = e_ < 64 ? a.w_e_up + (size_t)e_ * D * EH : a.w_s_up; N = EH; } \
        else { r -= 2 * I_GU; W = e_ < 64 ? a.w_e_down + (size_t)e_ * EH * D : a.w_s_down; N = D; } }
    float nv[32];
    if (gw < NIT) { CEW_SRC(gw, W0, N0, r0) p0_tr_load(nv, W0, N0, r0, F.lane); }
    for (int it = gw; it < NIT; it += NGW) {
        float cv[32];
#pragma unroll
        for (int i = 0; i < 32; ++i) cv[i] = nv[i];
        if (it + NGW < NIT) { CEW_SRC(it + NGW, W1, N1, r1) p0_tr_load(nv, W1, N1, r1, F.lane); }
        const int e = it / I_E; int r = it - e * I_E;
        bf16* wgu8 = (bf16*)((unsigned char*)WguT + (size_t)e * 512 * D);
        if (r < I_GU) { p0_tr_finish(cv, D, EH, wgu8, 0, 1, 0, scr, r, F.lane, D, 0, WGU_SCALE); continue; } r -= I_GU;
        if (r < I_GU) { p0_tr_finish(cv, D, EH, wgu8, 0, 1, 1, scr, r, F.lane, D, 0, WGU_SCALE); continue; } r -= I_GU;
        p0_tr_finish(cv, EH, D, (bf16*)((unsigned char*)WdT + (size_t)e * D * EH), 0, 0, 0, scr, r, F.lane, EH, 0, WD_SCALE);
    }
#undef CEW_SRC
}
__device__ __forceinline__ void p0b_prologue(Frame& F, const Args& a) {
    LAS float* scr = (LAS float*)(F.lds + F.wave * 16384);
    const int gw = F.vcu * 8 + F.wave, NGW = F.G * 8;
    bf16* WinT = (bf16*)(a.ws + WS_WIN); bf16* WbsT = (bf16*)(a.ws + WS_WBS); bf16* WoT = (bf16*)(a.ws + WS_WO);
    constexpr int I_IN = 16 * (NIN / 32), I_BR = 8 * 32, I_O = 16 * 32;
    constexpr int NITEMS = I_IN + 2 * I_BR + I_O;
    for (int it = gw; it < NITEMS; it += NGW) {
        int r = it;
        if (r < I_IN) { p0_transpose_item(a.w_in, D, NIN, WinT, 0, 0, 0, scr, r, F.lane, D, 0, WIN_SCALE); continue; } r -= I_IN;
        if (r < I_BR) { p0_transpose_item(a.w_br_sb, 512, D, WbsT, 0, 0, 0, scr, r, F.lane, 1024, 0, WBS_SCALE); continue; } r -= I_BR;
        if (r < I_BR) { p0_transpose_item(a.w_br_hg, 512, D, WbsT, 0, 0, 0, scr, r, F.lane, 1024, 512, WBS_SCALE); continue; } r -= I_BR;
        p0_transpose_item(a.w_out, D, D, WoT, 0, 0, 0, scr, r, F.lane, D, 0, WO_SCALE);
    }
    const float* mod = (const float*)(a.ws + WS_MOD);
    unsigned char* H = (unsigned char*)a.out + 64 * MiB;
    f32x4 nv[4];
    if (gw < T) { const GAS f32x4* xr = (const GAS f32x4*)(a.x + (size_t)gw * D) + F.lane;
#pragma unroll
        for (int j = 0; j < 4; ++j) nv[j] = __builtin_nontemporal_load(xr + 64 * j); }
    f32x4 g1v[4];
#pragma unroll
    for (int j = 0; j < 4; ++j) g1v[j] = *(const f32x4*)(a.norm1_g + 4 * F.lane + 256 * j);
    for (int m = gw; m < T; m += NGW) {
        const int b = m >> 12;
        f32x4 v[4], shv[4], scv[4]; float s2 = 0.f;
#pragma unroll
        for (int j = 0; j < 4; ++j) { const int c0 = 4 * F.lane + 256 * j; shv[j] = *(const f32x4*)(mod + b * 6144 + c0); scv[j] = *(const f32x4*)(mod + b * 6144 + 1024 + c0); }
#pragma unroll
        for (int j = 0; j < 4; ++j) { v[j] = nv[j]; s2 += (v[j].x * v[j].x + v[j].y * v[j].y) + (v[j].z * v[j].z + v[j].w * v[j].w); }
        if (m + NGW < T) { const GAS f32x4* xr = (const GAS f32x4*)(a.x + (size_t)(m + NGW) * D) + F.lane;
#pragma unroll
            for (int j = 0; j < 4; ++j) nv[j] = __builtin_nontemporal_load(xr + 64 * j); }
        const float rstd = __builtin_amdgcn_rsqf(wave_sum(s2) * (1.f / D) + EPS);
        GAS unsigned* o8 = (GAS unsigned*)(H + (size_t)m * D) + F.lane;
#pragma unroll
        for (int j = 0; j < 4; ++j) { const f32x4 y = v[j] * rstd * g1v[j] * (scv[j] + 1.0f) + shv[j];
            o8[64 * j] = pk4_fp8(y.x, y.y, y.z, y.w); }
    }
}

struct SchedDense {
    pg8::DenseOrder O; const char* A; const char* B; int lda, ldb;
    __device__ __forceinline__ bool next(int i, pg8::Unit& u) const { int pm, pn; if (!O.tile(i, pm, pn)) return false; u.pm = pm; u.pn = pn; u.z = 0; u.r0 = 0; u.nr = 256; u.ar = 0; return true; }
    __device__ __forceinline__ const char* a_base(const pg8::Unit& u) const { return A + (size_t)u.pm * 256 * lda * 2; }
    __device__ __forceinline__ const char* b_base(const pg8::Unit& u) const { return B + (size_t)u.pn * 256 * ldb * 2; }
    __device__ __forceinline__ unsigned a_row(const pg8::Unit&, int) const { return 0u; }
};
struct EpiProj {
    static constexpr int PERM = 2;
    bf16* proj; unsigned char* gates; LAS unsigned char* stg; int shadow;
    __device__ __forceinline__ void operator()(const f32x4 (&acc)[2][2][4][2], const pg8::Unit& u, int wr, int wc, int fr, int fq) const {
#ifdef PROBE_NOEPI
        if (shadow) return;
#endif
        constexpr float IS = 1.f / WIN_SCALE;
        if (u.pn < 14) {
            LAS unsigned char* sw = stg + (wr * 4 + wc) * 2048;
            const int l = fq * 16 + fr, rr = l >> 3, ch = l & 7;
            bf16* gp = proj + ((size_t)(u.pm * 16 + wr * 4) * 56 + (u.pn * 4 + wc)) * 1024 + l * 8;
#pragma unroll
            for (int ai = 0; ai < 2; ++ai)
#pragma unroll
                for (int m = 0; m < 4; ++m) {
                    const f32x4 v0 = acc[ai][0][m][0] * IS, v1 = acc[ai][0][m][1] * IS, v2 = acc[ai][1][m][0] * IS, v3 = acc[ai][1][m][1] * IS;
                    v4u w0, w1; w0.x = pg8::cvt_pk_bf16(v0[0], v0[1]); w0.y = pg8::cvt_pk_bf16(v0[2], v0[3]); w0.z = pg8::cvt_pk_bf16(v1[0], v1[1]); w0.w = pg8::cvt_pk_bf16(v1[2], v1[3]);
                    w1.x = pg8::cvt_pk_bf16(v2[0], v2[1]); w1.y = pg8::cvt_pk_bf16(v2[2], v2[3]); w1.z = pg8::cvt_pk_bf16(v3[0], v3[1]); w1.w = pg8::cvt_pk_bf16(v3[2], v3[3]);
                    *(LAS v4u*)(sw + fr * 128 + fq * 32) = w0; *(LAS v4u*)(sw + fr * 128 + fq * 32 + 16) = w1;
                    asm volatile("s_waitcnt lgkmcnt(0)" ::: "memory");
                    const v4u r0 = *(const LAS v4u*)(sw + rr * 128 + ch * 16), r1 = *(const LAS v4u*)(sw + (rr + 8) * 128 + ch * 16);
                    bf16* bp = gp + (size_t)(ai * 8 + m) * 56 * 1024;
                    __builtin_nontemporal_store(r0, (v4u*)bp); __builtin_nontemporal_store(r1, (v4u*)(bp + 512)); }
        } else {
            const int row0 = u.pm * 256 + wr * 64 + fr, col0 = (u.pn - 14) * 256 + wc * 64 + 16 * fq;
#pragma unroll
            for (int ai = 0; ai < 2; ++ai)
#pragma unroll
                for (int m = 0; m < 4; ++m) { unsigned char* rowp = gates + (size_t)(row0 + ai * 128 + m * 16) * NG + col0;
                    const f32x4 v0 = acc[ai][0][m][0] * IS, v1 = acc[ai][0][m][1] * IS, v2 = acc[ai][1][m][0] * IS, v3 = acc[ai][1][m][1] * IS;
                    v4u w; w.x = pk4_fp8(v0[0], v0[1], v0[2], v0[3]); w.y = pk4_fp8(v1[0], v1[1], v1[2], v1[3]); w.z = pk4_fp8(v2[0], v2[1], v2[2], v2[3]); w.w = pk4_fp8(v3[0], v3[1], v3[2], v3[3]);
                    __builtin_nontemporal_store(w, (v4u*)rowp); }
        }
    }
};
namespace sba {
typedef float f32x2_t __attribute__((ext_vector_type(2))); typedef __bf16 bf16x2_t __attribute__((ext_vector_type(2)));
__device__ __forceinline__ unsigned cvtpk(float lo, float hi) { f32x2_t v = {lo, hi}; bf16x2_t b = __builtin_convertvector(v, bf16x2_t); return __builtin_bit_cast(unsigned, b); }
__device__ __forceinline__ int crow(int r, int hi) { return (r & 3) + 8 * (r >> 2) + 4 * hi; }
constexpr int LK = 0, LV = 16384, LFLAG = 32768, LOST = 33024;
constexpr float DONE_THR = 1e-37f;

struct TileRegs { v4u k, v; };
__device__ __forceinline__ void tile_load(TileRegs& R, const bf16* proj, int b, int h, int kb, int tid) {
    const int key = tid >> 3, ch = tid & 7; const size_t row = (size_t)(b * SEQ + kb + key);
    R.k = *(const v4u*)(proj + proj_at(row, COL_K + h * 64 + ch * 8)); R.v = *(const v4u*)(proj + proj_at(row, COL_V + h * 64 + ch * 8));
}
__device__ __forceinline__ void tile_store(const TileRegs& R, LAS unsigned char* lds, int buf, const float (&gk)[8], int tid) {
    const int key = tid >> 3, ch = tid & 7;
    float v[8]; v[0] = bflo(R.k.x); v[1] = bfhi(R.k.x); v[2] = bflo(R.k.y); v[3] = bfhi(R.k.y); v[4] = bflo(R.k.z); v[5] = bfhi(R.k.z); v[6] = bflo(R.k.w); v[7] = bfhi(R.k.w);
    float ss = 0.f;
#pragma unroll
    for (int i = 0; i < 8; ++i) ss += v[i] * v[i];
    ss += __shfl_xor(ss, 1); ss += __shfl_xor(ss, 2); ss += __shfl_xor(ss, 4);
    const float rstd = __builtin_amdgcn_rsqf(ss * (1.f / 64.f) + EPS);
    v4u o; o.x = cvtpk(v[0] * rstd * gk[0], v[1] * rstd * gk[1]); o.y = cvtpk(v[2] * rstd * gk[2], v[3] * rstd * gk[3]); o.z = cvtpk(v[4] * rstd * gk[4], v[5] * rstd * gk[5]); o.w = cvtpk(v[6] * rstd * gk[6], v[7] * rstd * gk[7]);
    *(LAS v4u*)(lds + LK + buf * 8192 + key * 128 + ((ch ^ (key & 7)) << 4)) = o;
    *(LAS v4u*)(lds + LV + buf * 8192 + (ch >> 2) * 4096 + key * 64 + (ch & 3) * 16) = R.v;
}

__device__ __forceinline__ void attn_unit(const Args& a, int b, int h, int qblk, LAS unsigned char* lds, const int wv) {
    const int tid = fresh_tid(wv), lane = tid & 63, r32 = lane & 31, hi = lane >> 5; const int wid = wv;
    const bf16* proj = (const bf16*)(a.ws + WS_PROJ);
    unsigned char* obuf = (unsigned char*)a.out;
    const int q0 = qblk * 256, qw = q0 + wid * 32;
    volatile LAS int* flags = (volatile LAS int*)(lds + LFLAG);
    float gk[8];
#pragma unroll
    for (int i = 0; i < 8; ++i) gk[i] = a.sb_k_g[(tid & 7) * 8 + i];
    const int ntile = (q0 + 256) / 64;
    TileRegs R;
    tile_load(R, proj, b, h, 64 * (ntile - 1), tid);
    bf16x8 qr[4];
    {
        const bf16* qrow = proj + proj_at((size_t)(b * SEQ + qw + r32), COL_Q + h * 64 + hi * 8);
        v4u raw[4]; float ss = 0.f;
#pragma unroll
        for (int d0 = 0; d0 < 4; ++d0) { raw[d0] = *(const v4u*)(qrow + d0 * 16);
            const float x0 = bflo(raw[d0].x), x1 = bfhi(raw[d0].x), x2 = bflo(raw[d0].y), x3 = bfhi(raw[d0].y), x4 = bflo(raw[d0].z), x5 = bfhi(raw[d0].z), x6 = bflo(raw[d0].w), x7 = bfhi(raw[d0].w);
            ss += (x0 * x0 + x1 * x1) + (x2 * x2 + x3 * x3) + (x4 * x4 + x5 * x5) + (x6 * x6 + x7 * x7); }
        ss += __shfl_xor(ss, 32);
        const float rs = (0.125f * 1.44269504f) / sqrtf(ss * (1.f / 64.f) + EPS);
#pragma unroll
        for (int d0 = 0; d0 < 4; ++d0) { const float* g = a.sb_q_g + d0 * 16 + hi * 8;
            v4u o; o.x = cvtpk(bflo(raw[d0].x) * rs * g[0], bfhi(raw[d0].x) * rs * g[1]); o.y = cvtpk(bflo(raw[d0].y) * rs * g[2], bfhi(raw[d0].y) * rs * g[3]);
            o.z = cvtpk(bflo(raw[d0].z) * rs * g[4], bfhi(raw[d0].z) * rs * g[5]); o.w = cvtpk(bflo(raw[d0].w) * rs * g[6], bfhi(raw[d0].w) * rs * g[7]);
            qr[d0] = __builtin_bit_cast(bf16x8, o); }
    }
    tile_store(R, lds, 0, gk, tid);
    if (tid < 16) flags[tid] = 0;
    __syncthreads();
    f32x16 o0 = {}, o1 = {};
    float carry = 1.f; bool done = false;
    const int i16 = lane & 15;
    const int vlane = ((lane >> 4) & 1) * 32 + (i16 & 3) * 8 + (4 * hi + (i16 >> 2)) * 64;
    for (int it = 0; it < ntile; ++it) {
        const int jt = ntile - 1 - it, kb = 64 * jt, cur = it & 1; const bool has_next = jt > 0;
        if (has_next) tile_load(R, proj, b, h, kb - 64, tid);
        if (!done && kb < qw + 31) {
            const LAS unsigned char* Kb = lds + LK + cur * 8192; const LAS unsigned char* Vb = lds + LV + cur * 8192;
            f32x16 p0 = {}, p1 = {};
            __builtin_amdgcn_s_setprio(1);
#pragma unroll
            for (int d0 = 0; d0 < 4; ++d0) {
                const int c = 2 * d0 + hi;
                const bf16x8 k0 = *(const LAS bf16x8*)(Kb + r32 * 128 + ((c ^ (r32 & 7)) << 4));
                const bf16x8 k1 = *(const LAS bf16x8*)(Kb + (32 + r32) * 128 + ((c ^ (r32 & 7)) << 4));
                p0 = __builtin_amdgcn_mfma_f32_32x32x16_bf16(k0, qr[d0], p0, 0, 0, 0);
                p1 = __builtin_amdgcn_mfma_f32_32x32x16_bf16(k1, qr[d0], p1, 0, 0, 0);
            }
            __builtin_amdgcn_s_setprio(0);
            const int qrel = qw + r32 - kb;
            const bool need_mask = (kb + 63 >= qw);
            float R0[16], R1[16];
#pragma unroll
            for (int r = 0; r < 16; ++r) {
                const int k0i = crow(r, hi), k1i = 32 + k0i;
                const float e0 = __builtin_amdgcn_exp2f(fminf(p0[r], 115.f)), e1 = __builtin_amdgcn_exp2f(fminf(p1[r], 115.f));
                float r0 = __builtin_amdgcn_rcpf(1.0f + e0), r1 = __builtin_amdgcn_rcpf(1.0f + e1);
                float b0 = e0 * r0, b1 = e1 * r1;
                if (need_mask) { if (k0i >= qrel) { r0 = 1.f; b0 = 0.f; } if (k1i >= qrel) { r1 = 1.f; b1 = 0.f; } }
                R0[r] = r0; R1[r] = r1; p0[r] = b0; p1[r] = b1;
            }
            float gs[8], pg[8];
#pragma unroll
            for (int g = 0; g < 4; ++g) { gs[g] = (R0[4 * g] * R0[4 * g + 1]) * (R0[4 * g + 2] * R0[4 * g + 3]); gs[4 + g] = (R1[4 * g] * R1[4 * g + 1]) * (R1[4 * g + 2] * R1[4 * g + 3]); }
#pragma unroll
            for (int g = 0; g < 8; ++g) pg[g] = __shfl_xor(gs[g], 32);
            float run = carry;
#pragma unroll
            for (int idx = 7; idx >= 0; --idx) {
                const int g = idx & 3;
                float e = hi == 0 ? run * pg[idx] : run;
                if (idx >= 4) {
#pragma unroll
                    for (int i = 3; i >= 0; --i) { const int r = 4 * g + i; p1[r] *= e; e *= R1[r]; }
                } else {
#pragma unroll
                    for (int i = 3; i >= 0; --i) { const int r = 4 * g + i; p0[r] *= e; e *= R0[r]; }
                }
                run *= gs[idx] * pg[idx];
            }
            carry = run;
            __builtin_amdgcn_s_setprio(1);
#pragma unroll
            for (int kk = 0; kk < 4; ++kk) {
                v4u pw;
                if (kk == 0)      { pw.x = cvtpk(p0[0], p0[1]);  pw.y = cvtpk(p0[2], p0[3]);   pw.z = cvtpk(p0[4], p0[5]);   pw.w = cvtpk(p0[6], p0[7]); }
                else if (kk == 1) { pw.x = cvtpk(p0[8], p0[9]);  pw.y = cvtpk(p0[10], p0[11]); pw.z = cvtpk(p0[12], p0[13]); pw.w = cvtpk(p0[14], p0[15]); }
                else if (kk == 2) { pw.x = cvtpk(p1[0], p1[1]);  pw.y = cvtpk(p1[2], p1[3]);   pw.z = cvtpk(p1[4], p1[5]);   pw.w = cvtpk(p1[6], p1[7]); }
                else              { pw.x = cvtpk(p1[8], p1[9]);  pw.y = cvtpk(p1[10], p1[11]); pw.z = cvtpk(p1[12], p1[13]); pw.w = cvtpk(p1[14], p1[15]); }
                const bf16x8 pa = __builtin_bit_cast(bf16x8, pw);
                const LAS unsigned char* vp = Vb + kk * 1024 + vlane;
                const s16x4 a0 = __builtin_bit_cast(s16x4, __builtin_amdgcn_ds_read_tr16_b64_v4i16((LAS s16x4*)(vp)));
                const s16x4 a1 = __builtin_bit_cast(s16x4, __builtin_amdgcn_ds_read_tr16_b64_v4i16((LAS s16x4*)(vp + 512)));
                const s16x4 b0 = __builtin_bit_cast(s16x4, __builtin_amdgcn_ds_read_tr16_b64_v4i16((LAS s16x4*)(vp + 4096)));
                const s16x4 b1 = __builtin_bit_cast(s16x4, __builtin_amdgcn_ds_read_tr16_b64_v4i16((LAS s16x4*)(vp + 4096 + 512)));
                const bf16x8 vf0 = __builtin_shufflevector(a0, a1, 0, 1, 2, 3, 4, 5, 6, 7), vf1 = __builtin_shufflevector(b0, b1, 0, 1, 2, 3, 4, 5, 6, 7);
                o0 = __builtin_amdgcn_mfma_f32_32x32x16_bf16(pa, vf0, o0, 0, 0, 0);
                o1 = __builtin_amdgcn_mfma_f32_32x32x16_bf16(pa, vf1, o1, 0, 0, 0);
            }
            __builtin_amdgcn_s_setprio(0);
            done = __all(carry < DONE_THR);
        }
        if (has_next) tile_store(R, lds, cur ^ 1, gk, tid);
        if (lane == 0) flags[cur * 8 + wid] = done ? 1 : 0;
        __syncthreads();
        if (!has_next) break;
        int nd = 0;
#pragma unroll
        for (int w = 0; w < 8; ++w) nd += flags[cur * 8 + w];
        if (nd == 8) break;
    }
    {
        LAS unsigned char* stg = lds + LOST + wid * 4096;
#pragma unroll
        for (int r = 0; r < 16; ++r) { const int q = crow(r, hi); const unsigned pk = (unsigned)__builtin_amdgcn_cvt_pk_fp8_f32(fp8_clamp(o0[r]), fp8_clamp(o1[r]), 0, false);
            *(LAS unsigned char*)(stg + q * 64 + r32) = (unsigned char)(pk & 0xFFu); *(LAS unsigned char*)(stg + q * 64 + 32 + r32) = (unsigned char)((pk >> 8) & 0xFFu); }
        asm volatile("s_waitcnt lgkmcnt(0)" ::: "memory");
        unsigned char* orow = obuf + (size_t)(b * SEQ + qw) * 1024 + h * 64;
#pragma unroll
        for (int i = 0; i < 2; ++i) { const int row = i * 16 + (lane >> 2), ch = lane & 3; const v4u v = *(const LAS v4u*)(stg + row * 64 + ch * 16); *(v4u*)(orow + (size_t)row * 1024 + ch * 16) = v; }
    }
    __syncthreads();
}
}
namespace hg {
constexpr int RS128 = 272, RS64 = 144;
constexpr int L_KH = 0, L_QH = 17408, L_RG = 34816, L_KT = 52224, L_VT = 70656, L_PP = 89088, L_ST = 98304, L_TOT = 133120, L_SS = 141312;
static_assert(L_SS + 512 <= LDSCTL_OFF, "HGRN2 LDS map");
__device__ __forceinline__ f32x4 mma16(const LAS unsigned char* A, int ars, const LAS unsigned char* B, int brs, int ksteps, int lane, f32x4 acc) {
    const int r = lane & 15, kq = lane >> 4;
#pragma unroll 4
    for (int ks = 0; ks < ksteps; ++ks) {
        const bf16x8 av = *(const LAS bf16x8*)(A + r * ars + (32 * ks + 8 * kq) * 2);
        const bf16x8 bv = *(const LAS bf16x8*)(B + r * brs + (32 * ks + 8 * kq) * 2);
        acc = __builtin_amdgcn_mfma_f32_16x16x32_bf16(av, bv, acc, 0, 0, 0);
    }
    return acc;
}
#define HG_BAR() do { asm volatile("s_waitcnt lgkmcnt(0)" ::: "memory"); __builtin_amdgcn_s_barrier(); asm volatile("" ::: "memory"); } while (0)
__device__ __forceinline__ unsigned cvtpk(float lo, float hi) { return pg8::cvt_pk_bf16(lo, hi); }
__device__ __forceinline__ float ex2(float x) { return __builtin_amdgcn_exp2f(x); }
__device__ __forceinline__ float lg2(float x) { return __builtin_amdgcn_logf(x); }
template <bool FULL> struct Raw { v4u f[2], i[2], q[FULL ? 2 : 1], g[FULL ? 2 : 1]; };
template <bool FULL>
__device__ __forceinline__ void raw_load(Raw<FULL>& R, const bf16* proj, size_t t0, int h, int tid) {
    const size_t row = t0 + (tid >> 3); const int c = h * 128 + (tid & 7) * 8;
#pragma unroll
    for (int j = 0; j < 2; ++j) { R.f[j] = *(const v4u*)(proj + proj_at(row, COL_F + c + 64 * j)); R.i[j] = *(const v4u*)(proj + proj_at(row, COL_I + c + 64 * j));
        if constexpr (FULL) { R.q[j] = *(const v4u*)(proj + proj_at(row, COL_HQ + c + 64 * j)); R.g[j] = *(const v4u*)(proj + proj_at(row, COL_HG + c + 64 * j)); } }
}
template <bool FULL, int ABL = 0>
__device__ __forceinline__ void segment(const Args& a, int b, int h, int seg, LAS unsigned char* lds, const int wv) {
    const int tid = fresh_tid(wv), lane = tid & 63; const int w = wv;
    const bf16* proj = (const bf16*)(a.ws + WS_PROJ);
    unsigned char* obuf = (unsigned char*)a.out + (ABL ? (size_t)32 * 1024 * 1024 : 0);
    float* Lbuf = (float*)(a.ws + WS_HGL); float* Gbuf = (float*)(a.ws + WS_HGG);
    const int ubase = (b * 4 + h) * 8;
    const float lb0 = fsigmoid(a.hg_lb[h * 128 + 2 * lane] - a.hg_lb[512 + h * 128 + 2 * lane]), lb1 = fsigmoid(a.hg_lb[h * 128 + 2 * lane + 1] - a.hg_lb[512 + h * 128 + 2 * lane + 1]);
    const float om0 = 1.f - lb0, om1 = 1.f - lb1;
    LAS float* TOT = (LAS float*)(lds + L_TOT);
    LAS float* SS = (LAS float*)(lds + L_SS);
    const size_t tseg = (size_t)b * SEQ + seg * 512;
    Raw<FULL> R;
    raw_load<FULL>(R, proj, tseg, h, tid);
    f32x4 S[8]; float Gacc[4] = {0.f, 0.f, 0.f, 0.f};
#pragma unroll
    for (int ni = 0; ni < 8; ++ni) S[ni] = (f32x4){0.f, 0.f, 0.f, 0.f};
    const int dd0 = 16 * w + 4 * (lane >> 4), vl = lane & 15;
    if constexpr (FULL) {
        for (int i = 0; i < seg; ++i) {
            const float* Li = Lbuf + (size_t)(ubase + i) * 16384; const float* Gi = Gbuf + (ubase + i) * 128;
#pragma unroll
            for (int r = 0; r < 4; ++r) { const float eg = ex2(Gi[dd0 + r]);
#pragma unroll
                for (int ni = 0; ni < 8; ++ni) S[ni][r] = eg * S[ni][r] + Li[(dd0 + r) * 128 + 16 * ni + vl]; }
        }
    }
    const int sc = tid >> 3, sch = tid & 7;
    for (int n = 0; n < 8; ++n) {
        const int par = n & 1; const size_t t0 = tseg + n * 64;
#pragma unroll
        for (int j = 0; j < 2; ++j) { const int off = sc * RS128 + (sch * 8 + 64 * j) * 2;
            *(LAS v4u*)(lds + L_KH + off) = R.f[j]; *(LAS v4u*)(lds + L_RG + off) = R.i[j];
            if constexpr (FULL) *(LAS v4u*)(lds + L_QH + off) = R.q[j]; }
        v4u gkeep[2];
        if constexpr (FULL) { gkeep[0] = R.g[0]; gkeep[1] = R.g[1]; }
        if (n < 7) raw_load<FULL>(R, proj, t0 + 64, h, tid);
        HG_BAR();
        float cs0[8] = {}, cs1[8] = {}, kk0[8] = {}, kk1[8] = {}; float run0 = 0.f, run1 = 0.f;
#pragma unroll
        for (int i = 0; i < (ABL == 3 ? 0 : 8); ++i) { const unsigned fw = *(const LAS unsigned*)(lds + L_KH + (8 * w + i) * RS128 + lane * 4);
            const float s0 = fsigmoid(bflo(fw)), s1 = fsigmoid(bfhi(fw));
            run0 += lg2(lb0 + om0 * s0); run1 += lg2(lb1 + om1 * s1); cs0[i] = run0; cs1[i] = run1; kk0[i] = om0 - om0 * s0; kk1[i] = om1 - om1 * s1; }
        *(LAS f32x2v*)(TOT + (par * 8 + w) * 128 + 2 * lane) = (f32x2v){run0, run1};
        HG_BAR();
        {
            float off0 = 0.f, off1 = 0.f, gref0 = 0.f, gref1 = 0.f;
#pragma unroll
            for (int p = 0; p < 4; ++p) { const f32x2v t = *(const LAS f32x2v*)(TOT + (par * 8 + p) * 128 + 2 * lane); gref0 += t.x; gref1 += t.y; if (p < w) { off0 += t.x; off1 += t.y; } }
#pragma unroll
            for (int p = 4; p < 7; ++p) { if (p < w) { const f32x2v t = *(const LAS f32x2v*)(TOT + (par * 8 + p) * 128 + 2 * lane); off0 += t.x; off1 += t.y; } }
            unsigned kt0[4] = {}, kt1[4] = {}, vt0[4] = {}, vt1[4] = {};
#pragma unroll
            for (int i = 0; i < (ABL == 3 ? 0 : 8); i += 2) {
                float kh0[2], kh1[2]; unsigned iw[2];
#pragma unroll
                for (int j = 0; j < 2; ++j) { const int c = 8 * w + i + j;
                    const float e10 = ex2(cs0[i + j] + off0 - gref0), e11 = ex2(cs1[i + j] + off1 - gref1);
                    kh0[j] = kk0[i + j] * __builtin_amdgcn_rcpf(e10); kh1[j] = kk1[i + j] * __builtin_amdgcn_rcpf(e11);
                    *(LAS unsigned*)(lds + L_KH + c * RS128 + lane * 4) = cvtpk(kh0[j], kh1[j]);
                    if constexpr (FULL) { LAS unsigned* qp = (LAS unsigned*)(lds + L_QH + c * RS128 + lane * 4); const unsigned qw = *qp; *qp = cvtpk(fsilu(bflo(qw)) * e10, fsilu(bfhi(qw)) * e11); }
                    iw[j] = *(const LAS unsigned*)(lds + L_RG + c * RS128 + lane * 4); }
                kt0[i >> 1] = cvtpk(kh0[0], kh0[1]); kt1[i >> 1] = cvtpk(kh1[0], kh1[1]);
                vt0[i >> 1] = (iw[0] & 0xffffu) | (iw[1] << 16); vt1[i >> 1] = (iw[0] >> 16) | (iw[1] & 0xffff0000u);
            }
            *(LAS v4u*)(lds + L_KT + (2 * lane) * RS64 + w * 16) = (v4u){kt0[0], kt0[1], kt0[2], kt0[3]}; *(LAS v4u*)(lds + L_KT + (2 * lane + 1) * RS64 + w * 16) = (v4u){kt1[0], kt1[1], kt1[2], kt1[3]};
            *(LAS v4u*)(lds + L_VT + (2 * lane) * RS64 + w * 16) = (v4u){vt0[0], vt0[1], vt0[2], vt0[3]}; *(LAS v4u*)(lds + L_VT + (2 * lane + 1) * RS64 + w * 16) = (v4u){vt1[0], vt1[1], vt1[2], vt1[3]};
            if constexpr (FULL) {
                float eg[4];
#pragma unroll
                for (int r = 0; r < 4; ++r) { const LAS float* tp = TOT + par * 1024 + dd0 + r; eg[r] = ex2((tp[0] + tp[128]) + (tp[256] + tp[384])); }
#pragma unroll
                for (int ni = 0; ni < 8; ++ni) { v2u o; o.x = cvtpk(S[ni][0] * eg[0], S[ni][1] * eg[1]); o.y = cvtpk(S[ni][2] * eg[2], S[ni][3] * eg[3]);
                    *(LAS v2u*)(lds + L_ST + (16 * ni + vl) * RS128 + dd0 * 2) = o; }
            }
        }
        HG_BAR();
        if constexpr (FULL) {
#pragma unroll
            for (int j = 0; j < 2; ++j) *(LAS v4u*)(lds + L_RG + sc * RS128 + (sch * 8 + 64 * j) * 2) = gkeep[j];
        }
        if constexpr (FULL) {
            const int mi = w >> 1;
#pragma unroll
            for (int j = 0; j < 2; ++j) { const int ni = 2 * (w & 1) + j;
                f32x4 acc = (f32x4){0.f, 0.f, 0.f, 0.f};
                if (ABL != 2 && ni <= mi) acc = mma16(lds + L_QH + 16 * mi * RS128, RS128, lds + L_KH + 16 * ni * RS128, RS128, 4, lane, acc);
                const int s = 16 * ni + vl;
#pragma unroll
                for (int r = 0; r < 4; ++r) { const int c = 16 * mi + 4 * (lane >> 4) + r; *(LAS bf16*)(lds + L_PP + c * RS64 + s * 2) = (bf16)f2bf(s <= c ? acc[r] : 0.f); } }
            HG_BAR();
        }
        f32x4 oacc[4];
        if constexpr (FULL) {
            const int mi = w >> 1;
#pragma unroll
            for (int j = 0; j < 4; ++j) { const int ni = 4 * (w & 1) + j;
                f32x4 acc = (f32x4){0.f, 0.f, 0.f, 0.f};
                if constexpr (ABL != 2) { acc = mma16(lds + L_PP + 16 * mi * RS64, RS64, lds + L_VT + 16 * ni * RS64, RS64, 2, lane, acc);
                acc = mma16(lds + L_QH + 16 * mi * RS128, RS128, lds + L_ST + 16 * ni * RS128, RS128, 4, lane, acc); }
                oacc[j] = acc; }
        }
        {
            float egl[4], e1[4];
#pragma unroll
            for (int r = 0; r < 4; ++r) { const LAS float* tp = TOT + par * 1024 + dd0 + r; const float gr = (tp[0] + tp[128]) + (tp[256] + tp[384]), gl = gr + (tp[512] + tp[640]) + (tp[768] + tp[896]);
                egl[r] = ex2(gl); e1[r] = ex2(gl - gr); Gacc[r] += gl; }
#pragma unroll
            for (int ni = 0; ni < 8; ++ni) {
                f32x4 kv = (f32x4){0.f, 0.f, 0.f, 0.f};
                if constexpr (ABL != 2) kv = mma16(lds + L_KT + 16 * w * RS64, RS64, lds + L_VT + 16 * ni * RS64, RS64, 2, lane, kv);
#pragma unroll
                for (int r = 0; r < 4; ++r) S[ni][r] = egl[r] * S[ni][r] + e1[r] * kv[r];
            }
        }
        if constexpr (FULL && ABL != 1) {
            const int mi = w >> 1;
#pragma unroll
            for (int r = 0; r < 4; ++r) { float s = 0.f;
#pragma unroll
                for (int j = 0; j < 4; ++j) s += oacc[j][r] * oacc[j][r];
                s += __shfl_xor(s, 1); s += __shfl_xor(s, 2); s += __shfl_xor(s, 4); s += __shfl_xor(s, 8);
                if (vl == 0) SS[(16 * mi + 4 * (lane >> 4) + r) * 2 + (w & 1)] = s; }
            HG_BAR();
#pragma unroll
            for (int r = 0; r < 4; ++r) { const int c = 16 * mi + 4 * (lane >> 4) + r; const float rstd = __builtin_amdgcn_rsqf((SS[c * 2] + SS[c * 2 + 1]) * (1.f / 128.f) + EPS);
#pragma unroll
                for (int j = 0; j < 4; ++j) { const int v = 16 * (4 * (w & 1) + j) + vl;
                    const float g = bf2f(*(const LAS bf16*)(lds + L_RG + c * RS128 + v * 2));
                    *(LAS unsigned char*)(lds + L_QH + c * RS128 + v) = (unsigned char)((unsigned)__builtin_amdgcn_cvt_pk_fp8_f32(fp8_clamp(oacc[j][r] * rstd * a.hg_norm_g[v] * fsilu(g)), 0.f, 0, false) & 0xFFu); } }
            HG_BAR();
            { const v4u ov = *(const LAS v4u*)(lds + L_QH + sc * RS128 + sch * 16);
              *(v4u*)(obuf + (t0 + sc) * 1024 + 512 + h * 128 + sch * 16) = ov; }
        }
        HG_BAR();
    }
    if constexpr (!FULL) {
        float* Lo = Lbuf + (size_t)(ubase + seg) * 16384; float* Go = Gbuf + (ubase + seg) * 128;
#pragma unroll
        for (int r = 0; r < 4; ++r) {
#pragma unroll
            for (int ni = 0; ni < 8; ++ni) Lo[(dd0 + r) * 128 + 16 * ni + vl] = S[ni][r];
            if (vl == 0) Go[dd0 + r] = Gacc[r]; }
    }
}
}
struct EpiBranch {
    static constexpr int PERM = 1;
    const unsigned char* gates; unsigned char* merged;
    __device__ __forceinline__ void mid(f32x4 (&acc)[2][2][4][2], const pg8::Unit& u, int wr, int wc, int fr, int fq) const {
        const int row0 = u.pm * 256 + wr * 64 + fr, col0 = u.pn * 256 + wc * 32 + 8 * fq;
#pragma unroll
        for (int ai = 0; ai < 2; ++ai) {
            v2u g1[4][2], g2[4][2];
#pragma unroll
            for (int m = 0; m < 4; ++m)
#pragma unroll
                for (int bj = 0; bj < 2; ++bj) { const unsigned char* gp = gates + (size_t)(row0 + ai * 128 + m * 16) * NG + col0 + bj * 128; g1[m][bj] = *(const v2u*)gp; g2[m][bj] = *(const v2u*)(gp + 1024); }
#pragma unroll
            for (int m = 0; m < 4; ++m)
#pragma unroll
                for (int bj = 0; bj < 2; ++bj) { const unsigned a1x = g1[m][bj].x, a1y = g1[m][bj].y, a2x = g2[m][bj].x, a2y = g2[m][bj].y;
#define RHO(x1, x2) ((1.0f + __expf(-fmaxf(x2, -20.f))) * __builtin_amdgcn_rcpf(1.0f + __expf(-(x1))))
                    const auto p0 = __builtin_amdgcn_cvt_pk_f32_fp8((int)a1x, false), p1 = __builtin_amdgcn_cvt_pk_f32_fp8((int)a1x, true), p2 = __builtin_amdgcn_cvt_pk_f32_fp8((int)a1y, false), p3 = __builtin_amdgcn_cvt_pk_f32_fp8((int)a1y, true);
                    const auto q0 = __builtin_amdgcn_cvt_pk_f32_fp8((int)a2x, false), q1 = __builtin_amdgcn_cvt_pk_f32_fp8((int)a2x, true), q2 = __builtin_amdgcn_cvt_pk_f32_fp8((int)a2y, false), q3 = __builtin_amdgcn_cvt_pk_f32_fp8((int)a2y, true);
                    f32x4& v0 = acc[ai][bj][m][0]; f32x4& v1 = acc[ai][bj][m][1];
                    v0[0] *= RHO(p0[0], q0[0]); v0[1] *= RHO(p0[1], q0[1]); v0[2] *= RHO(p1[0], q1[0]); v0[3] *= RHO(p1[1], q1[1]);
                    v1[0] *= RHO(p2[0], q2[0]); v1[1] *= RHO(p2[1], q2[1]); v1[2] *= RHO(p3[0], q3[0]); v1[3] *= RHO(p3[1], q3[1]);
#undef RHO
                }
            asm volatile("" ::: "memory"); }
    }
    __device__ __forceinline__ void operator()(const f32x4 (&acc)[2][2][4][2], const pg8::Unit& u, int wr, int wc, int fr, int fq) const {
        const int row0 = u.pm * 256 + wr * 64 + fr, col0 = u.pn * 256 + wc * 32 + 8 * fq;
#pragma unroll
        for (int ai = 0; ai < 2; ++ai) {
            v2u g[4][2];
#pragma unroll
            for (int m = 0; m < 4; ++m)
#pragma unroll
                for (int bj = 0; bj < 2; ++bj) g[m][bj] = *(const v2u*)(gates + (size_t)(row0 + ai * 128 + m * 16) * NG + 1024 + col0 + bj * 128);
#pragma unroll
            for (int m = 0; m < 4; ++m)
#pragma unroll
                for (int bj = 0; bj < 2; ++bj) { const size_t row = (size_t)(row0 + ai * 128 + m * 16); const int c = col0 + bj * 128;
                    const f32x4 v0 = acc[ai][bj][m][0], v1 = acc[ai][bj][m][1]; const unsigned gx = g[m][bj].x, gy = g[m][bj].y;
                    const auto p0 = __builtin_amdgcn_cvt_pk_f32_fp8((int)gx, false), p1 = __builtin_amdgcn_cvt_pk_f32_fp8((int)gx, true), p2 = __builtin_amdgcn_cvt_pk_f32_fp8((int)gy, false), p3 = __builtin_amdgcn_cvt_pk_f32_fp8((int)gy, true);
#define SG(x) ((1.f / WBS_SCALE) * fsigmoid(fmaxf(x, -20.f)))
                    v2u w; w.x = pk4_fp8(SG(p0[0]) * v0[0], SG(p0[1]) * v0[1], SG(p1[0]) * v0[2], SG(p1[1]) * v0[3]);
                    w.y = pk4_fp8(SG(p2[0]) * v1[0], SG(p2[1]) * v1[1], SG(p3[0]) * v1[2], SG(p3[1]) * v1[3]);
#undef SG
                    *(v2u*)(merged + row * 1024 + c) = w; }
            asm volatile("" ::: "memory"); }
    }
};
struct EpiXmid {
    static constexpr int PERM = 1;
    const float* x; const float* mod; bf16* xmid;
    __device__ __forceinline__ void operator()(const f32x4 (&acc)[2][2][4][2], const pg8::Unit& u, int wr, int wc, int fr, int fq) const {
        const int row0 = u.pm * 256 + wr * 64 + fr, col0 = u.pn * 256 + wc * 32 + 8 * fq; const int b = (u.pm * 256) >> 12;
        f32x4 g1[2][2];
#pragma unroll
        for (int bj = 0; bj < 2; ++bj)
#pragma unroll
            for (int n = 0; n < 2; ++n) g1[bj][n] = *(const f32x4*)(mod + b * 6144 + 2048 + col0 + bj * 128 + n * 4) * (1.f / WO_SCALE);
#pragma unroll
        for (int ai = 0; ai < 2; ++ai)
#pragma unroll
            for (int m = 0; m < 4; ++m) { const size_t off = (size_t)(row0 + ai * 128 + m * 16) * 1024 + col0;
#pragma unroll
                for (int bj = 0; bj < 2; ++bj) { const f32x4 x0 = *(const f32x4*)(x + off + bj * 128), x1 = *(const f32x4*)(x + off + bj * 128 + 4);
                    const f32x4 y0 = x0 + g1[bj][0] * acc[ai][bj][m][0], y1 = x1 + g1[bj][1] * acc[ai][bj][m][1];
                    v4u w; w.x = pg8::cvt_pk_bf16(y0[0], y0[1]); w.y = pg8::cvt_pk_bf16(y0[2], y0[3]); w.z = pg8::cvt_pk_bf16(y1[0], y1[1]); w.w = pg8::cvt_pk_bf16(y1[2], y1[3]);
                    *(v4u*)(xmid + off + bj * 128) = w; } }
    }
};
namespace rt {
constexpr int HTS = 2064;
constexpr int L_HTH = 0, L_HTL = 33024, L_RED = 66048, L_ASG = 98816, L_CNTL = 107008, L_BASE = 107520, L_SC = 108032, L_LOG = 109056;
static_assert(L_LOG + 32768 <= LDSCTL_OFF, "router LDS map");
__device__ __forceinline__ void route_block(Frame& F, const Args& a, int blk, int shadow) {
    const int tid = F.tid, lane = F.lane, w = F.wave;
    const float* mod = (const float*)(a.ws + WS_MOD); unsigned char* H2 = a.ws + WS_H2;
    LAS float* RED = (LAS float*)(F.lds + L_RED); LAS unsigned* ASG = (LAS unsigned*)(F.lds + L_ASG);
    LAS int* CNTL = (LAS int*)(F.lds + L_CNTL); LAS int* BASE = (LAS int*)(F.lds + L_BASE); LAS float* LOG = (LAS float*)(F.lds + L_LOG);
    const int tok0 = blk * 128; const int b = tok0 >> 12;
    const float bias = a.router_bias[fresh_lane()];
    LAS float* MA = (LAS float*)(F.lds + EPI_STG_OFF); LAS float* MB = MA + 1024;
    for (int c = tid; c < 1024; c += 512) { MA[c] = a.norm2_g[c] * (mod[b * 6144 + 4096 + c] + 1.0f); MB[c] = mod[b * 6144 + 3072 + c]; }
    __syncthreads();
    bf16x8 whi[4][4], wlo[4][4];
    { const int n = lane & 15, kq = lane >> 4;
      const float* wp = a.w_router + (size_t)(128 * w + 8 * kq) * 64 + n; asm volatile("" : "+v"(wp));
#pragma unroll
      for (int ks = 0; ks < 4; ++ks)
#pragma unroll
          for (int nb = 0; nb < 4; ++nb) { float f[8];
#pragma unroll
              for (int j = 0; j < 8; ++j) f[j] = wp[(32 * ks + j) * 64 + 16 * nb];
              v4u h, l;
              h.x = pg8::cvt_pk_bf16(f[0], f[1]); h.y = pg8::cvt_pk_bf16(f[2], f[3]); h.z = pg8::cvt_pk_bf16(f[4], f[5]); h.w = pg8::cvt_pk_bf16(f[6], f[7]);
              l.x = pg8::cvt_pk_bf16(f[0] - bflo(h.x), f[1] - bfhi(h.x)); l.y = pg8::cvt_pk_bf16(f[2] - bflo(h.y), f[3] - bfhi(h.y)); l.z = pg8::cvt_pk_bf16(f[4] - bflo(h.z), f[5] - bfhi(h.z)); l.w = pg8::cvt_pk_bf16(f[6] - bflo(h.w), f[7] - bfhi(h.w));
              whi[ks][nb] = __builtin_bit_cast(bf16x8, h); wlo[ks][nb] = __builtin_bit_cast(bf16x8, l); } }
    asm volatile("" ::: "memory");
#define RT_BAR() do { asm volatile("s_waitcnt lgkmcnt(0)" ::: "memory"); __builtin_amdgcn_s_barrier(); asm volatile("" ::: "memory"); } while (0)
    v2u nx[2][4];
#pragma unroll
    for (int rr = 0; rr < 2; ++rr) { const GAS v2u* xp = (const GAS v2u*)((const bf16*)(a.ws + WS_XMID) + (size_t)(tok0 + 2 * w + rr) * D) + lane;
#pragma unroll
        for (int j = 0; j < 4; ++j) nx[rr][j] = xp[64 * j]; }
    for (int bt = 0; bt < 8; ++bt) {
        int lane_b = lane; asm volatile("" : "+v"(lane_b));
#pragma unroll
        for (int rr = 0; rr < 2; ++rr) {
            const int tl = 2 * w + rr, m = tok0 + 16 * bt + tl;
            f32x4 v[4]; float s2 = 0.f;
#pragma unroll
            for (int j = 0; j < 4; ++j) { const v2u xb = nx[rr][j]; v[j] = (f32x4){bflo(xb.x), bfhi(xb.x), bflo(xb.y), bfhi(xb.y)}; s2 += (v[j].x * v[j].x + v[j].y * v[j].y) + (v[j].z * v[j].z + v[j].w * v[j].w); }
            const float rstd = __builtin_amdgcn_rsqf(wave_sum(s2) * (1.f / D) + EPS);
            GAS unsigned* o8 = (GAS unsigned*)(H2 + (size_t)m * D) + lane_b;
#pragma unroll
            for (int j = 0; j < 4; ++j) { const int c0 = 4 * lane_b + 256 * j;
                const f32x4 ma = *(const LAS f32x4*)(MA + c0), mb = *(const LAS f32x4*)(MB + c0);
                const f32x4 y = v[j] * rstd * ma + mb;
                o8[64 * j] = pk4_fp8(y.x, y.y, y.z, y.w);
                { v2u h, l; h.x = pg8::cvt_pk_bf16(y.x, y.y); h.y = pg8::cvt_pk_bf16(y.z, y.w);
                  l.x = pg8::cvt_pk_bf16(y.x - bflo(h.x), y.y - bfhi(h.x)); l.y = pg8::cvt_pk_bf16(y.z - bflo(h.y), y.w - bfhi(h.y));
                  *(LAS v2u*)(F.lds + L_HTH + tl * HTS + c0 * 2) = h; *(LAS v2u*)(F.lds + L_HTL + tl * HTS + c0 * 2) = l; }
                asm volatile("" ::: "memory"); }
        }
        if (bt < 7) {
#pragma unroll
            for (int rr = 0; rr < 2; ++rr) { const GAS v2u* xp = (const GAS v2u*)((const bf16*)(a.ws + WS_XMID) + (size_t)(tok0 + 16 * (bt + 1) + 2 * w + rr) * D) + lane_b;
#pragma unroll
                for (int j = 0; j < 4; ++j) nx[rr][j] = xp[64 * j]; } }
        RT_BAR();
        {
            f32x4 acc[4];
#pragma unroll
            for (int nb = 0; nb < 4; ++nb) acc[nb] = (f32x4){0.f, 0.f, 0.f, 0.f};
            const int i = lane_b & 15, kq = lane_b >> 4;
#pragma unroll
            for (int ks = 0; ks < 4; ++ks) {
                const bf16x8 ah = *(const LAS bf16x8*)(F.lds + L_HTH + i * HTS + (128 * w + 32 * ks + 8 * kq) * 2);
                const bf16x8 al = *(const LAS bf16x8*)(F.lds + L_HTL + i * HTS + (128 * w + 32 * ks + 8 * kq) * 2);
#pragma unroll
                for (int nb = 0; nb < 4; ++nb) {
                    acc[nb] = __builtin_amdgcn_mfma_f32_16x16x32_bf16(al, whi[ks][nb], acc[nb], 0, 0, 0);
                    acc[nb] = __builtin_amdgcn_mfma_f32_16x16x32_bf16(ah, wlo[ks][nb], acc[nb], 0, 0, 0);
                    acc[nb] = __builtin_amdgcn_mfma_f32_16x16x32_bf16(ah, whi[ks][nb], acc[nb], 0, 0, 0); } }
#pragma unroll
            for (int nb = 0; nb < 4; ++nb)
#pragma unroll
                for (int r = 0; r < 4; ++r) RED[(w * 16 + 4 * kq + r) * 64 + 16 * nb + i] = acc[nb][r];
        }
        RT_BAR();
#pragma unroll
        for (int rr = 0; rr < 2; ++rr) { const int tl = 2 * w + rr; float logit = 0.f;
#pragma unroll
            for (int p = 0; p < 8; ++p) logit += RED[(p * 16 + tl) * 64 + lane_b];
            LOG[(16 * bt + tl) * 64 + lane_b] = logit; }
    }
    RT_BAR();
    const int lane_b = fresh_lane();
    for (int tq = 0; tq < 16; ++tq) {
        {
            const int tloc = 16 * w + tq; const float logit = LOG[tloc * 64 + lane_b];
            const float score = fsigmoid(logit), choice = score + bias;
#if DBG_CHECK
            ((float*)(a.ws + WS_ACT + 4 * MiB))[(size_t)(tok0 + tloc) * 64 + lane_b] = logit;
#endif
            const int g = lane_b >> 3;
            int rk = 0;
#pragma unroll
            for (int j = 1; j < 8; ++j) { const int ol = (lane_b & ~7) | ((lane_b + j) & 7); const float o = __shfl(choice, ol); rk += (o > choice || (o == choice && ol < lane_b)) ? 1 : 0; }
            float gsum = rk < 2 ? choice : 0.f; gsum += __shfl_xor(gsum, 1); gsum += __shfl_xor(gsum, 2); gsum += __shfl_xor(gsum, 4);
            int grk = 0;
#pragma unroll
            for (int j = 1; j < 8; ++j) { const int og = (g + j) & 7; const float o = __shfl(gsum, og * 8); grk += (o > gsum || (o == gsum && og < g)) ? 1 : 0; }
            const float mc = grk < 4 ? choice : -INFINITY;
            const unsigned mb = __builtin_bit_cast(unsigned, mc); const unsigned key = mb ^ ((mb >> 31) ? 0xFFFFFFFFu : 0x80000000u);
            unsigned thr = 0u;
#pragma unroll
            for (int bit = 31; bit >= 0; --bit) { const unsigned t = thr | (1u << bit); const int c = __builtin_popcountll(__ballot(key >= t)); thr = (c >= 8) ? t : thr; }
            const unsigned long long gtm = __ballot(key > thr), eqm = __ballot(key == thr);
            const int need = 8 - __builtin_popcountll(gtm);
            const int epos = (int)__builtin_amdgcn_mbcnt_hi((unsigned)(eqm >> 32), __builtin_amdgcn_mbcnt_lo((unsigned)eqm, 0u));
            const bool sel = (key > thr) || (key == thr && epos < need);
            const unsigned long long selm = __ballot(sel);
            const int erk = (int)__builtin_amdgcn_mbcnt_hi((unsigned)(selm >> 32), __builtin_amdgcn_mbcnt_lo((unsigned)selm, 0u));
            LAS float* SC = (LAS float*)(F.lds + L_SC) + w * 8;
            if (sel) SC[erk] = score;
            float ssum = 0.f;
#pragma unroll
            for (int j = 0; j < 8; ++j) ssum += SC[j];
            if (sel) { const int tok = tok0 + tloc;
                ASG[(tloc * 8 + erk) * 2] = (unsigned)tok | ((unsigned)erk << 16) | ((unsigned)lane_b << 19);
                ASG[(tloc * 8 + erk) * 2 + 1] = __builtin_bit_cast(unsigned, score / ssum * 2.5f); }
        }
    }
    const int tz = fresh_tid(w);
    if (tz < 64) CNTL[tz] = 0;
    __syncthreads();
    unsigned w0[2], w1[2]; int rnk[2];
#pragma unroll
    for (int j = 0; j < 2; ++j) { const int idx = tz + 512 * j; w0[j] = ASG[idx * 2]; w1[j] = ASG[idx * 2 + 1]; rnk[j] = atomicAdd((int*)&CNTL[w0[j] >> 19], 1); }
    __syncthreads();
    { const int tq = fresh_tid(w);
      if (tq < 64) { const int c = CNTL[tq]; BASE[tq] = c ? (int)__hip_atomic_fetch_add((unsigned*)(F.ctl + (shadow ? 65536 : CW_CNT) + 64 * tq), (unsigned)c, RLX_AGENT) : 0; } }
    __syncthreads();
    v2u* lists = (v2u*)(a.ws + (shadow ? WS_ACT : WS_LIST));
#pragma unroll
    for (int j = 0; j < 2; ++j) { const int ve = w0[j] >> 19; lists[(size_t)ve * T + BASE[ve] + rnk[j]] = (v2u){w0[j] & 0x7FFFFu, w1[j]}; }
#if DBG_CHECK
    { v2u* dbg = (v2u*)(a.ws + WS_ACT);
#pragma unroll
      for (int j = 0; j < 2; ++j) { const int idx = tid + 512 * j; dbg[(size_t)tok0 * 8 + idx] = (v2u){w0[j], w1[j]}; } }
#endif
    __syncthreads();
}
}
namespace ex {
constexpr int MAXT = 5, EN_OFF = RING_BYTES;
static_assert(EN_OFF + MAXT * 2048 <= LDSCTL_OFF, "entry cache");
__device__ __forceinline__ void build_tables(Frame& F, const v2u* lists) {
    LAS int* TP = (LAS int*)(F.lds + TAB_OFF); LAS int* PS = TP + 66; LAS int* CN = PS + 66; LAS int* UT = TP + 256;
    if (F.tid == 0) {
        int cnt[65];
#pragma unroll
        for (int ve = 0; ve < 64; ++ve) cnt[ve] = (int)__hip_atomic_load(F.ctl + CW_CNT + 64 * ve, RLX_AGENT);
        cnt[64] = T;
        int tp = 0, ps = 0;
#pragma unroll
        for (int ve = 0; ve <= 64; ++ve) { TP[ve] = tp; PS[ve] = ve < 64 ? ps : ACT_SH0; CN[ve] = cnt[ve]; tp += (cnt[ve] + 255) >> 8; ps += ((cnt[ve] + 255) >> 8) << 8; }
        TP[65] = tp;
    }
    __syncthreads();
    if (F.tid < 8) {
        const int L = F.tid * F.G + F.vcu; int ve = -1, r0 = 0, nr = 0, ar = 0;
        if (L < TP[65]) { int lo = 0, hi = 64; while (lo < hi) { const int mid = (lo + hi + 1) >> 1; if (TP[mid] <= L) lo = mid; else hi = mid - 1; }
            ve = lo; r0 = (L - TP[lo]) << 8; const int rem = CN[lo] - r0; nr = rem < 256 ? rem : 256; ar = PS[lo] + r0; }
        UT[F.tid * 4] = ve; UT[F.tid * 4 + 1] = r0; UT[F.tid * 4 + 2] = nr; UT[F.tid * 4 + 3] = ar;
    }
    __syncthreads();
    LAS v2u* EN = (LAS v2u*)(F.lds + EN_OFF);
    for (int e = F.tid; e < MAXT * 256; e += 512) { const int j = e >> 8, r = e & 255; const int ve = UT[j * 4], r0 = UT[j * 4 + 1], nr = UT[j * 4 + 2];
        v2u en = (v2u){0u, 0u};
        if (ve == 64) en = (v2u){(unsigned)(r0 + (r < nr ? r : 0)) | (8u << 16), 0x3f800000u};
        else if (ve >= 0 && r < nr) en = lists[(size_t)ve * T + r0 + r];
        EN[e] = en; }
    __syncthreads();
}
__device__ __forceinline__ bool unit_tile(const LAS int* UT, int j, pg8::Unit& u) {
    if (j >= MAXT) return false;
    const int ve = __builtin_amdgcn_readfirstlane(UT[j * 4]); if (ve < 0) return false;
    u.z = ve; u.r0 = __builtin_amdgcn_readfirstlane(UT[j * 4 + 1]); u.nr = __builtin_amdgcn_readfirstlane(UT[j * 4 + 2]); u.ar = __builtin_amdgcn_readfirstlane(UT[j * 4 + 3]); u.pm = j;
    return true;
}
struct SchedGU {
    const LAS int* UT; const LAS v2u* EN; const char* H2; const char* Wgu; int lda, ldb;
    __device__ __forceinline__ bool next(int i, pg8::Unit& u) const { if (!unit_tile(UT, i >> 1, u)) return false; u.pn = i & 1; return true; }
    __device__ __forceinline__ const char* a_base(const pg8::Unit&) const { return H2; }
    __device__ __forceinline__ const char* b_base(const pg8::Unit& u) const { const int e = u.z; return Wgu + ((size_t)e * 512 + u.pn * 256) * 1024; }
    __device__ __forceinline__ unsigned a_row(const pg8::Unit& u, int R) const {
        return EN[u.pm * 256 + R].x & 0xFFFFu;
    }
};
using ::pk4_fp8;
struct EpiAct {
    static constexpr int PERM = 1;
    unsigned char* act;
    __device__ __forceinline__ void operator()(const f32x4 (&acc)[2][2][4][2], const pg8::Unit& u, int wr, int wc, int fr, int fq) const {
        const int hc0 = u.pn * 128 + wc * 32 + 8 * fq;
#pragma unroll
        for (int ai = 0; ai < 2; ++ai)
#pragma unroll
            for (int m = 0; m < 4; ++m) { const int rloc = ai * 128 + wr * 64 + m * 16 + fr;
#define SWG(g, u) (((g) * (u)) * (ACT_SCALE / (WGU_SCALE * WGU_SCALE)) * __builtin_amdgcn_rcpf(1.0f + __builtin_amdgcn_exp2f((g) * (-1.44269504f / WGU_SCALE))))
                const f32x4 g0 = acc[ai][0][m][0], g1 = acc[ai][0][m][1], u0 = acc[ai][1][m][0], u1 = acc[ai][1][m][1];
                v2u w; w.x = pk4_fp8(SWG(g0[0], u0[0]), SWG(g0[1], u0[1]), SWG(g0[2], u0[2]), SWG(g0[3], u0[3]));
                w.y = pk4_fp8(SWG(g1[0], u1[0]), SWG(g1[1], u1[1]), SWG(g1[2], u1[2]), SWG(g1[3], u1[3]));
#undef SWG
                *(v2u*)(act + (size_t)(u.ar + rloc) * EH + hc0) = w; asm volatile("" ::: "memory"); }
    }
};
struct SchedDown {
    const LAS int* UT; const char* Act; const char* Wd; int lda, ldb;
    __device__ __forceinline__ bool next(int i, pg8::Unit& u) const { if (!unit_tile(UT, i >> 2, u)) return false; u.pn = i & 3; return true; }
    __device__ __forceinline__ const char* a_base(const pg8::Unit& u) const { return Act + (size_t)u.ar * EH; }
    __device__ __forceinline__ const char* b_base(const pg8::Unit& u) const { const int e = u.z; return Wd + ((size_t)e * 1024 + u.pn * 256) * EH; }
    __device__ __forceinline__ unsigned a_row(const pg8::Unit&, int) const { return 0u; }
};
__device__ __forceinline__ unsigned char* y_row(unsigned char* ws, int tok, int slot) {
    if (slot == 8) return ws + (tok < 16384 ? WS_YS0 : WS_YS1) + (size_t)(tok & 16383) * 1024;
    const int q = tok >> 13; const size_t base = q == 0 ? WS_Y0 : (q == 1 ? WS_Y1 : (q == 2 ? WS_Y2 : WS_Y3));
    return ws + base + ((size_t)(tok & 8191) * 8 + slot) * 1024;
}
struct EpiDown {
    static constexpr int PERM = 2;
    unsigned char* ws; const LAS v2u* EN; int shadow;
    __device__ __forceinline__ void operator()(const f32x4 (&acc)[2][2][4][2], const pg8::Unit& u, int wr, int wc, int fr, int fq) const {
        const int col0 = u.pn * 256 + wc * 64 + 16 * fq;
#ifdef PROBE_NOEPI
        if (shadow) return;
#endif
        v2u en[2][4];
#pragma unroll
        for (int ai = 0; ai < 2; ++ai)
#pragma unroll
            for (int m = 0; m < 4; ++m) { const int rloc = ai * 128 + wr * 64 + m * 16 + fr; en[ai][m] = EN[u.pm * 256 + rloc]; }
#pragma unroll
        for (int ai = 0; ai < 2; ++ai)
#pragma unroll
            for (int m = 0; m < 4; ++m) { const int rloc = ai * 128 + wr * 64 + m * 16 + fr;
                if (rloc < u.nr) {
                    const unsigned ex = en[ai][m].x, ey = en[ai][m].y; const int tok = ex & 0xFFFFu, slot = (ex >> 16) & 15; const float wgt = __uint_as_float(ey) * (Y_SCALE / (ACT_SCALE * WD_SCALE));
                    const f32x4 v0 = acc[ai][0][m][0] * wgt, v1 = acc[ai][0][m][1] * wgt, v2 = acc[ai][1][m][0] * wgt, v3 = acc[ai][1][m][1] * wgt;
                    v4u w; w.x = pk4_fp8(v0[0], v0[1], v0[2], v0[3]); w.y = pk4_fp8(v1[0], v1[1], v1[2], v1[3]); w.z = pk4_fp8(v2[0], v2[1], v2[2], v2[3]); w.w = pk4_fp8(v3[0], v3[1], v3[2], v3[3]);
#ifdef PROBE_NOSTORE
                    if (shadow) { asm volatile("" :: "v"(w.x), "v"(w.y), "v"(w.z), "v"(w.w), "v"(tok), "v"(slot)); } else
#endif
#ifdef PROBE_DENSEY
                    if (shadow) *(v4u*)(ws + 116 * MiB + (size_t)((u.ar + rloc) & 131071) * 1024 + col0) = w; else
#endif
                    __builtin_nontemporal_store(w, (v4u*)(y_row(ws, tok, slot) + col0)); } }
    }
};
__device__ __forceinline__ void combine(Frame& F, const Args& a, float* out_w) {
    const float* mod = (const float*)(a.ws + WS_MOD);
    const int gw = F.vcu * 8 + F.wave, NGW = F.G * 8;
    for (int tok = gw; tok < T; tok += NGW) {
        const int b = tok >> 12; const GAS v2u* op = (const GAS v2u*)((const bf16*)(a.ws + WS_XMID) + (size_t)tok * D) + F.lane; GAS f32x4* ow = (GAS f32x4*)(out_w + (size_t)tok * D) + F.lane;
        const unsigned char* y0 = ex::y_row(a.ws, tok, 0); const unsigned char* ysh = ex::y_row(a.ws, tok, 8);
#pragma unroll
        for (int j = 0; j < 4; ++j) { const int c0 = 4 * F.lane + 256 * j; f32x4 s = (f32x4){0.f, 0.f, 0.f, 0.f};
#pragma unroll
            for (int sl = 0; sl < 9; ++sl) { const int p = *(const int*)((sl < 8 ? y0 + sl * 1024 : ysh) + c0); const auto lo = __builtin_amdgcn_cvt_pk_f32_fp8(p, false), hi = __builtin_amdgcn_cvt_pk_f32_fp8(p, true); s += (f32x4){lo[0], lo[1], hi[0], hi[1]}; }
            const f32x4 g2 = *(const f32x4*)(mod + b * 6144 + 5120 + c0) * (1.f / Y_SCALE);
            const v2u xb = op[64 * j];
            ow[64 * j] = (f32x4){bflo(xb.x), bfhi(xb.x), bflo(xb.y), bfhi(xb.y)} + g2 * s; }
    }
}
}
constexpr int NPHASE = 11;
__global__ void __launch_bounds__(512, 2) mk_fwd(Args a) {
    extern __shared__ __attribute__((aligned(16))) unsigned char lds[];
    Frame F;
    F.lds = (LAS unsigned char*)lds;
    F.MISC = (volatile LAS unsigned*)(F.lds + MISC_OFF);
    const int WV = __builtin_amdgcn_readfirstlane((int)threadIdx.x >> 6);
    F.tid = fresh_tid(WV); F.lane = F.tid & 63; F.wave = WV;
    F.G = gridDim.x; { const int bx = blockIdx.x; F.vcu = (F.G % 8 == 0) ? (bx % 8) * (F.G / 8) + bx / 8 : bx; }
    F.ctl = (gu32*)(a.ws + WS_CTL);
    for (int u = F.tid; u < (LDS_BYTES - LDSCTL_OFF) / 4; u += 512) ((LAS unsigned*)(F.lds + LDSCTL_OFF))[u] = 0u;
    __syncthreads();
    const int lo = a.ph_lo, hi = a.ph_hi;
    const bool multi = (hi - lo) > 1;
    XcdBarrier bar; bar.bar = (unsigned*)(F.ctl + CW_BAR); bar.x = 0; bar.st = nullptr; bar.wv = WV;
    if (multi) bar = xcd_barrier_post((unsigned*)(F.ctl + CW_BAR), F.MISC + 8, WV);
#ifndef PHASE_MASK
#define PHASE_MASK 0xFFF
#endif
#define IN(k) (((PHASE_MASK >> (k)) & 1) && lo <= (k) && (k) < hi)
#define GRID_BAR(k) do { if (IN((k) + 1)) xcd_barrier(bar); } while (0)
#ifndef REPEAT_MASK
#define REPEAT_MASK 0
#endif
#define REP(k) for (int rep_ = 0; rep_ <= ((REPEAT_MASK >> (k)) & 1); ++rep_)
#define REP_BAR(k) do { if (rep_ < ((REPEAT_MASK >> (k)) & 1) && multi) xcd_barrier(bar); } while (0)
#ifndef NO_DESYNC
#define DESYNC(n, s) do { const int g_ = (int)((blockIdx.x >> 3) & 3) * (n); for (int d_ = 0; d_ < g_; ++d_) __builtin_amdgcn_s_sleep(s); } while (0)
#else
#define DESYNC(n, s) do { } while (0)
#endif
#define FRESH() do { const int t_ = fresh_tid(WV); F.tid = t_; F.lane = t_ & 63; F.wave = WV; } while (0)

    if (IN(0)) { REP(0) { FRESH(); p0a_mod(F, a); REP_BAR(0); } GRID_BAR(0); }
    if (IN(1)) { REP(1) { FRESH(); p0b_prologue(F, a); REP_BAR(1); } GRID_BAR(1); }
    if (IN(2)) REP(2) {
        SchedDense S; S.O.init(T, NIN, F.G, (int)blockIdx.x); S.A = (const char*)a.out + 64 * MiB; S.B = (const char*)(a.ws + WS_WIN); S.lda = D / 2; S.ldb = D / 2;
        EpiProj E{(bf16*)(a.ws + WS_PROJ), a.ws + WS_GATES, F.lds + EPI_STG_OFF, (int)(rep_ < ((REPEAT_MASK >> 2) & 1))};
#ifdef DESYNC_HALF
        if ((blockIdx.x >> 3) & 1) { __builtin_amdgcn_s_sleep(125); __builtin_amdgcn_s_sleep(125); }
#endif
        pg8::gemm_phase<EpiProj, SchedDense, false, 512, 512, 512, false, true>(F.lds, S, E, WV);
        REP_BAR(2); if (rep_ == ((REPEAT_MASK >> 2) & 1)) GRID_BAR(2);
    }
    if (IN(3)) REP(3) {
        FRESH();
        if (rep_ == 0 && (blockIdx.x & 1)) { __syncthreads(); convert_expert_weights(F, a, F.lds + 69632); __syncthreads(); }
        for (int u = F.vcu; u < 1024; u += F.G) sba::attn_unit(a, u >> 7, (u >> 4) & 7, (u & 15) ^ (5 * (u >> 8)), F.lds, WV);
        if (rep_ == 0 && !(blockIdx.x & 1)) { __syncthreads(); convert_expert_weights(F, a, F.lds + 69632); __syncthreads(); }
        for (int u = F.vcu; u < 256; u += F.G) hg::segment<false>(a, u >> 5, (u >> 3) & 3, u & 7, F.lds, WV);
        REP_BAR(3); if (rep_ == ((REPEAT_MASK >> 3) & 1)) GRID_BAR(3);
    }
    if (IN(4)) REP(4) {
#ifdef HG_ABL
        if (rep_) { for (int u = blockIdx.x; u < 256; u += F.G) hg::segment<true, HG_ABL>(a, u >> 5, (u >> 3) & 3, u & 7, F.lds, WV); } else
#endif
        for (int u = F.vcu; u < 256; u += F.G) hg::segment<true>(a, u >> 5, (u >> 3) & 3, u & 7, F.lds, WV);
        REP_BAR(4); if (rep_ == ((REPEAT_MASK >> 4) & 1)) GRID_BAR(4);
    }
    if (IN(5)) REP(5) {
        SchedDense S; S.O.init(T, D, F.G, (int)blockIdx.x); S.A = (const char*)a.out; S.B = (const char*)(a.ws + WS_WBS); S.lda = D / 2; S.ldb = D / 2;
        EpiBranch E{a.ws + WS_GATES, a.ws + WS_MERGED};
        pg8::gemm_phase<EpiBranch, SchedDense, false, 512, 512, 512, true, true>(F.lds, S, E, WV);
        REP_BAR(5); if (rep_ == ((REPEAT_MASK >> 5) & 1)) GRID_BAR(5);
    }
    if (IN(6)) REP(6) {
        SchedDense S; S.O.init(T, D, F.G, (int)blockIdx.x); S.A = (const char*)(a.ws + WS_MERGED); S.B = (const char*)(a.ws + WS_WO); S.lda = D / 2; S.ldb = D / 2;
        EpiXmid E{a.x, (const float*)(a.ws + WS_MOD), (bf16*)(a.ws + WS_XMID)};
        pg8::gemm_phase<EpiXmid, SchedDense, false, 512, 512, 512, false, true>(F.lds, S, E, WV);
        REP_BAR(6); if (rep_ == ((REPEAT_MASK >> 6) & 1)) GRID_BAR(6);
    }
    if (IN(7)) REP(7) {
        FRESH();
        for (int blk = blockIdx.x; blk < T / 128; blk += F.G) rt::route_block(F, a, blk, rep_);
        REP_BAR(7); if (rep_ == ((REPEAT_MASK >> 7) & 1)) GRID_BAR(7);
    }
    if (IN(8)) REP(8) {
        FRESH(); __syncthreads(); ex::build_tables(F, (const v2u*)(a.ws + WS_LIST));
        ex::SchedGU S; S.UT = (const LAS int*)(F.lds + TAB_OFF) + 256; S.EN = (const LAS v2u*)(F.lds + ex::EN_OFF);
        S.H2 = (const char*)(a.ws + WS_H2); S.Wgu = (const char*)(a.ws + WS_WGU); S.lda = D / 2; S.ldb = D / 2;
        ex::EpiAct E{a.ws + WS_ACT};
        pg8::gemm_phase<ex::EpiAct, ex::SchedGU, true, 512, 512, 512, false, true>(F.lds, S, E, WV);
        REP_BAR(8); if (rep_ == ((REPEAT_MASK >> 8) & 1)) GRID_BAR(8);
    }
    if (IN(9)) REP(9) {
        FRESH(); __syncthreads();
        if (rep_ == 0 && !IN(8)) ex::build_tables(F, (const v2u*)(a.ws + WS_LIST));
        ex::SchedDown S; S.UT = (const LAS int*)(F.lds + TAB_OFF) + 256;
        S.Act = (const char*)(a.ws + WS_ACT); S.Wd = (const char*)(a.ws + WS_WD); S.lda = EH / 2; S.ldb = EH / 2;
        ex::EpiDown E{a.ws, (const LAS v2u*)(F.lds + ex::EN_OFF), rep_};
        pg8::gemm_phase<ex::EpiDown, ex::SchedDown, false, 128, 128, 128, false, true>(F.lds, S, E, WV);
        REP_BAR(9); if (rep_ == ((REPEAT_MASK >> 9) & 1)) GRID_BAR(9);
    }
    if (IN(10)) REP(10) { FRESH(); ex::combine(F, a, rep_ ? (float*)(a.ws + WS_ACT) : a.out); REP_BAR(10); }
#undef IN
#undef GRID_BAR
}

#if DBG_CHECK
__global__ void k_signature(Args a) {
    const unsigned w = *(const unsigned*)(a.ws + WS_CTL + 4 * CW_FAIL);
    if (!w) return;
    const float code = (float)(100 - (int)w);
    size_t i = (size_t)blockIdx.x * blockDim.x + threadIdx.x;
    for (; i < (size_t)T * D; i += (size_t)gridDim.x * blockDim.x) a.out[i] = -code * a.x[i];
}
#endif

extern "C" void kernel_launch(void* const* d_in, const int* in_sizes, int n_in, void* d_out, int out_size, void* d_ws, size_t ws_size, hipStream_t stream) {
    static int grid = 0;
    if (grid == 0) {
        if (n_in != 22 || out_size != T * D || ws_size < WS_END) { fprintf(stderr, "kernel_launch: unexpected shapes (n_in %d out %d ws %zu)\n", n_in, out_size, ws_size); grid = -1; return; }
        int dev = 0, cus = 0, per_cu = 0;
        if (hipGetDevice(&dev) != hipSuccess || hipDeviceGetAttribute(&cus, hipDeviceAttributeMultiprocessorCount, dev) != hipSuccess) { grid = -1; return; }
        if (hipFuncSetAttribute((const void*)mk_fwd, hipFuncAttributeMaxDynamicSharedMemorySize, LDS_BYTES) != hipSuccess) { fprintf(stderr, "kernel_launch: hipFuncSetAttribute failed\n"); grid = -1; return; }
        if (hipOccupancyMaxActiveBlocksPerMultiprocessor(&per_cu, (const void*)mk_fwd, 512, LDS_BYTES) != hipSuccess || per_cu < 1) fprintf(stderr, "kernel_launch: occupancy query reports %d\n", per_cu);
        (void)hipGetLastError();
        grid = cus;
    }
    if (grid < 0) return;
    (void)hipMemsetAsync((char*)d_ws + WS_CTL, 0, CTL_ZERO_BYTES, stream);
    Args a{};
    const float** p = (const float**)&a;
    for (int i = 0; i < 22; ++i) p[i] = (const float*)d_in[i];
    a.out = (float*)d_out; a.ws = (unsigned char*)d_ws;
#if MK_N_LAUNCHES == 1
    a.ph_lo = 0; a.ph_hi = NPHASE;
    hipLaunchKernelGGL(mk_fwd, dim3(grid), dim3(512), LDS_BYTES, stream, a);
#else
    for (int ph = 0; ph < NPHASE; ++ph) {
        a.ph_lo = ph; a.ph_hi = ph + 1;
        hipLaunchKernelGGL(mk_fwd, dim3(grid), dim3(512), LDS_BYTES, stream, a);
#if DBG_CHECK
        unsigned* ctl = (unsigned*)((char*)d_ws + WS_CTL); unsigned char* ws = (unsigned char*)d_ws;
        if (ph == 0) chk_mod<<<8, 256, 0, stream>>>(a, 1);
        if (ph == 1) {
            chk_wt<<<32, 256, 0, stream>>>(a.w_in, D, NIN, (const bf16*)(ws + WS_WIN), 0, 0, ctl, 2);
            chk_wt<<<8, 256, 0, stream>>>(a.w_br_sb, 512, D, (const bf16*)(ws + WS_WBS), 0, 0, ctl, 2);
            chk_wt<<<8, 256, 0, stream>>>(a.w_br_hg, 512, D, (const bf16*)(ws + WS_WBH), 0, 0, ctl, 2);
            chk_wt<<<8, 256, 0, stream>>>(a.w_out, D, D, (const bf16*)(ws + WS_WO), 0, 0, ctl, 2);
            for (int e = 0; e < 65; e += 9) {
                const float* wg = e < 64 ? a.w_e_gate + (size_t)e * D * EH : a.w_s_gate; const float* wu = e < 64 ? a.w_e_up + (size_t)e * D * EH : a.w_s_up; const float* wd = e < 64 ? a.w_e_down + (size_t)e * EH * D : a.w_s_down;
                chk_wt<<<8, 256, 0, stream>>>(wg, D, EH, (const bf16*)(ws + WS_WGU) + (size_t)e * 512 * D, 1, 0, ctl, 3);
                chk_wt<<<8, 256, 0, stream>>>(wu, D, EH, (const bf16*)(ws + WS_WGU) + (size_t)e * 512 * D, 1, 1, ctl, 3);
                chk_wt<<<8, 256, 0, stream>>>(wd, EH, D, (const bf16*)(ws + WS_WD) + (size_t)e * D * EH, 0, 0, ctl, 3);
            }
            chk_h<<<16, 256, 0, stream>>>(a, 4);
        }
        if (ph == 2) {
            chk_gemm_bf16<<<64, 256, 0, stream>>>((const bf16*)((char*)d_out + 64 * MiB), D, (const bf16*)(ws + WS_WIN), D, T, NA, D, (const bf16*)(ws + WS_PROJ), NA, 0, 0, ctl, 5);
            chk_gemm_bf16<<<64, 256, 0, stream>>>((const bf16*)((char*)d_out + 64 * MiB), D, (const bf16*)(ws + WS_WIN), D, T, NG, D, (const bf16*)(ws + WS_GATES), NG, 0, NA, ctl, 6);
        }
        if (ph == 4) {
            chk_attn<<<(1024 + 256) / 4, 256, 0, stream>>>(a, 7);
            chk_hgrn<<<4, 512, 0, stream>>>(a, 8, 1100);
        }
        if (ph == 5) chk_merged<<<32, 256, 0, stream>>>(a, 9);
        if (ph == 6) chk_xmid<<<32, 256, 0, stream>>>(a, 10);
        if (ph == 6) dbg_copy_xmid<<<128, 256, 0, stream>>>(a);
        if (ph == 7) { chk_route<<<16, 64, 0, stream>>>(a, 11); chk_route_fin<<<1, 64, 0, stream>>>(ctl, 11); dbg_copy_asg<<<128, 64, 0, stream>>>(a); chk_wsum<<<1, 128, 0, stream>>>(a, 15); }
        if (ph == 10) chk_final<<<128, 64, 0, stream>>>(a, 20);
        if (ph == 8) chk_act<<<32, 256, 0, stream>>>(a, 19);
#endif
    }
#endif
#if DBG_CHECK == 1
    k_signature<<<2048, 256, 0, stream>>>(a);
#endif
}
```

```cpp
#define MK_N_LAUNCHES 1
#define DBG_CHECK 0
#define REPEAT_MASK 0
#include <hip/hip_runtime.h>
#include <cstdio>
#include <cstdint>

#ifndef MK_N_LAUNCHES
#define MK_N_LAUNCHES 1
#endif
#ifndef DBG_CHECK
#define DBG_CHECK 0
#endif

#define GAS __attribute__((address_space(1)))
#define LAS __attribute__((address_space(3)))
typedef unsigned short bf16;
typedef unsigned v4u __attribute__((ext_vector_type(4)));
typedef unsigned v2u __attribute__((ext_vector_type(2)));
typedef float f32x4 __attribute__((ext_vector_type(4)));
typedef float f32x16 __attribute__((ext_vector_type(16)));
typedef float f32x2v __attribute__((ext_vector_type(2)));
typedef short bf16x8 __attribute__((ext_vector_type(8)));
typedef short s16x4 __attribute__((ext_vector_type(4)));
typedef int v4i_t __attribute__((ext_vector_type(4)));
typedef GAS unsigned gu32;
#define RLX_AGENT __ATOMIC_RELAXED, __HIP_MEMORY_SCOPE_AGENT
#define LDS_WAIT() asm volatile("s_waitcnt lgkmcnt(0)" ::: "memory")
#define VM_WAIT() asm volatile("s_waitcnt vmcnt(0)" ::: "memory")

__device__ __forceinline__ unsigned f2bf(float f) { unsigned u = __builtin_bit_cast(unsigned, f); return (u + 0x7fffu + ((u >> 16) & 1u)) >> 16; }
__device__ __forceinline__ unsigned pk2(float lo, float hi) { return f2bf(lo) | (f2bf(hi) << 16); }
__device__ __forceinline__ float bf2f(unsigned b) { return __builtin_bit_cast(float, b << 16); }
__device__ __forceinline__ float bflo(unsigned w) { return __builtin_bit_cast(float, w << 16); }
__device__ __forceinline__ float bfhi(unsigned w) { return __builtin_bit_cast(float, w & 0xffff0000u); }
__device__ __forceinline__ float fsigmoid(float x) { return __builtin_amdgcn_rcpf(1.0f + __expf(-x)); }
__device__ __forceinline__ float fsilu(float x) { return x * __builtin_amdgcn_rcpf(1.0f + __expf(-x)); }

__device__ __forceinline__ int fresh_lane() { int l; asm volatile("v_mbcnt_lo_u32_b32 %0, -1, 0\n\tv_mbcnt_hi_u32_b32 %0, -1, %0" : "=v"(l)); return l; }
__device__ __forceinline__ int fresh_tid(int wv) { return (wv << 6) | fresh_lane(); }

constexpr int NB = 8, SEQ = 4096, T = NB * SEQ, D = 1024;
constexpr int NA = 3584, NG = 2048, NIN = NA + NG;
constexpr int COL_Q = 0, COL_K = 512, COL_V = 1024, COL_F = 1536, COL_I = 2048, COL_HQ = 2560, COL_HG = 3072;
constexpr int NE = 64, EH = 256, NVE = 128;
constexpr float EPS = 1e-6f;
__device__ __forceinline__ size_t proj_at(size_t row, int col) { return ((row >> 4) * 56 + (size_t)(col >> 6)) * 1024 + (row & 15) * 64 + (col & 63); }

namespace pg8 {
#define PG8_LAS __attribute__((address_space(3)))
constexpr int BM = 256, BK = 64, HALF = 128, HTB = HALF * BK * 2, STAGE_BYTES = 8 * HTB, NXCD = 8, WGM = 4;
__host__ __device__ __forceinline__ int lds_byte(int r, int c) { const int st = (r >> 4) * 2 + (c >> 5), rr = r & 15, cc = c & 31, ob = rr * 64 + cc * 2; return st * 1024 + (ob ^ (((ob >> 9) & 1) << 5)); }
__host__ __device__ __forceinline__ void stage_rc(int b, int& R, int& C) { const int st = b / 1024, sb = b % 1024, swz = sb ^ (((sb >> 9) & 1) << 5); R = (st >> 1) * 16 + swz / 64; C = (st & 1) * 32 + (swz % 64) / 2; }
__host__ __device__ __forceinline__ int perm32(int rho) { const int n = rho >> 4, i = rho & 15; return 8 * (i >> 2) + 4 * n + (i & 3); }

struct Unit { int pm, pn, z, r0, nr, ar; };

struct DenseOrder {
    int nM, nN, nwg, G, c;
    __device__ void init(int M, int N, int G_, int c_) { nM = M / BM; nN = N / BM; nwg = nM * nN; G = G_; c = c_; }
    __device__ bool tile(int i, int& pm, int& pn) const {
        const long L = (long)i * G + c; if (L >= nwg) return false;
        int wgid = (int)L; { const int q = nwg / NXCD, r = nwg % NXCD, xcd = wgid % NXCD, off = wgid / NXCD; wgid = (xcd < r ? xcd * (q + 1) : r * (q + 1) + (xcd - r) * q) + off; }
        const int nig = WGM * nN, gid = wgid / nig, fm = gid * WGM, gsz = (nM - fm) < WGM ? (nM - fm) : WGM;
        pm = fm + ((wgid % nig) % gsz); pn = (wgid % nig) / gsz; return true;
    }
};

__device__ __forceinline__ unsigned cvt_pk_bf16(float lo, float hi) { unsigned r; asm volatile("v_cvt_pk_bf16_f32 %0, %1, %2" : "=v"(r) : "v"(lo), "v"(hi)); return r; }

template <class Epi, class Sched, bool GATHER, int K, int lda, int ldb, bool HOOK = false, bool FP8 = false>
__device__ __forceinline__ void gemm_phase(PG8_LAS unsigned char* lds, const Sched& S, const Epi& E, const int wv) {
    const int tid = fresh_tid(wv);
    const int wid = wv, lane = tid & 63, wr = wid >> 2, wc = wid & 3, fr = lane & 15, fq = lane >> 4;
    constexpr int nt = K / BK;
    unsigned voffA[2], voffB[2]; int RA[2], CA[2];
#pragma unroll
    for (int i = 0; i < 2; ++i) { int R, C; stage_rc(tid * 16 + i * 8192, R, C); const int Rb = Epi::PERM == 2 ? (64 * (R >> 5) + 16 * ((R >> 2) & 3) + 4 * ((R >> 4) & 1) + (R & 3)) : (Epi::PERM == 1 ? ((R & ~31) + perm32(R & 31)) : R);
        RA[i] = R; CA[i] = C; voffA[i] = (unsigned)(R * lda + C) * 2u; voffB[i] = (unsigned)(Rb * ldb + C) * 2u; }
    const size_t kstep = (size_t)(BK * 2);
    const size_t hstepA = (size_t)HALF * lda * 2, hstepB = (size_t)(Epi::PERM == 2 ? 8 : HALF) * ldb * 2;
    const unsigned ldsw = (unsigned)wid * 1024u;
    int aoff = lds_byte(wr * 64 + fr, fq * 8), boff = lds_byte(wc * 32 + fr, fq * 8);
#define PG8_SA(b, h) (((b) * 2 + (h)) * HTB)
#define PG8_SB(b, h) ((4 + (b) * 2 + (h)) * HTB)
#define PG8_STAGE(bufoff, gbase, voff) do { const char* _g = (const char*)(gbase); asm volatile("" : "+s"(_g));     \
        _Pragma("unroll") for (int _i = 0; _i < 2; ++_i) { unsigned _o = (voff)[_i]; asm volatile("" : "+v"(_o)); \
        __builtin_amdgcn_global_load_lds((const unsigned*)(_g + _o), (PG8_LAS unsigned*)(lds + (bufoff) + ldsw + _i * 8192), 16, 0, 0); } } while (0)
#define PG8_LDA(dst, b, h) do { _Pragma("unroll") for (int m = 0; m < 4; ++m) _Pragma("unroll") for (int k = 0; k < 2; ++k) dst[m][k] = *(const PG8_LAS bf16x8*)(lds + PG8_SA(b, h) + aoff + m * 2048 + k * 1024); } while (0)
#define PG8_LDB(dst, b, h) do { _Pragma("unroll") for (int n = 0; n < 2; ++n) _Pragma("unroll") for (int k = 0; k < 2; ++k) dst[n][k] = *(const PG8_LAS bf16x8*)(lds + PG8_SB(b, h) + boff + n * 2048 + k * 1024); } while (0)
#define PG8_CAT8(x) __builtin_shufflevector(__builtin_bit_cast(v4i_t, (x)[0]), __builtin_bit_cast(v4i_t, (x)[1]), 0, 1, 2, 3, 4, 5, 6, 7)
#define PG8_MMA(ai, bj, At, Bt) do { __builtin_amdgcn_s_setprio(1); \
        if constexpr (FP8) { _Pragma("unroll") for (int m = 0; m < 4; ++m) _Pragma("unroll") for (int n = 0; n < 2; ++n) \
            acc[ai][bj][m][n] = __builtin_amdgcn_mfma_scale_f32_16x16x128_f8f6f4(PG8_CAT8(Bt[n]), PG8_CAT8(At[m]), acc[ai][bj][m][n], 0, 0, 0, 0, 0, 0); } \
        else { _Pragma("unroll") for (int m = 0; m < 4; ++m) _Pragma("unroll") for (int n = 0; n < 2; ++n) _Pragma("unroll") for (int k = 0; k < 2; ++k) \
            acc[ai][bj][m][n] = __builtin_amdgcn_mfma_f32_16x16x32_bf16(Bt[n][k], At[m][k], acc[ai][bj][m][n], 0, 0, 0); } \
        __builtin_amdgcn_s_setprio(0); } while (0)
#define PG8_WAIT_V(n) asm volatile("s_waitcnt vmcnt(" #n ")" ::: "memory")
#define PG8_WAIT_L(n) asm volatile("s_waitcnt lgkmcnt(" #n ")" ::: "memory")
#define PG8_BAR __builtin_amdgcn_s_barrier()
#define PG8_SCHED __builtin_amdgcn_sched_barrier(0)
    Unit cur, nxt; int ui = 0;
    if (!S.next(0, cur)) return;
    f32x4 acc[2][2][4][2];
#pragma unroll
    for (int a = 0; a < 2; ++a)
#pragma unroll
        for (int b = 0; b < 2; ++b)
#pragma unroll
            for (int m = 0; m < 4; ++m)
#pragma unroll
                for (int n = 0; n < 2; ++n) acc[a][b][m][n] = (f32x4){0.f, 0.f, 0.f, 0.f};
    bf16x8 At[4][2], B0[2][2], B1[2][2];
    unsigned oc[2][2];
#pragma unroll
    for (int h = 0; h < 2; ++h)
#pragma unroll
        for (int i = 0; i < 2; ++i) oc[h][i] = GATHER ? (S.a_row(cur, RA[i] + h * HALF) * (unsigned)lda + (unsigned)CA[i]) * 2u : voffA[i];
#define PG8_OA(h) (GATHER ? oc[h] : voffA)
    const size_t hA = GATHER ? (size_t)0 : hstepA;
    const char* cA = S.a_base(cur); const char* cB = S.b_base(cur);
    PG8_STAGE(PG8_SB(0, 0), cB, voffB); PG8_STAGE(PG8_SB(0, 1), cB + hstepB, voffB); PG8_STAGE(PG8_SA(0, 0), cA, PG8_OA(0)); PG8_STAGE(PG8_SA(0, 1), cA + hA, PG8_OA(1));
    if (wr == 1) PG8_BAR;
    PG8_WAIT_V(2); PG8_BAR;
    PG8_STAGE(PG8_SB(1, 0), cB + kstep, voffB); PG8_STAGE(PG8_SA(1, 0), cA + kstep, PG8_OA(0)); PG8_STAGE(PG8_SB(1, 1), cB + hstepB + kstep, voffB);
    PG8_WAIT_V(6); PG8_BAR;
    for (;;) {
        const bool has_next = S.next(ui + 1, nxt);
        const char* nA = has_next ? S.a_base(nxt) : cA; const char* nB = has_next ? S.b_base(nxt) : cB;
        int ntv = nt; if constexpr (nt == 2) asm volatile("" : "+s"(ntv));
#pragma unroll 1
        for (int t = 0; t < ntv; t += 2) {
            const bool last = (t == ntv - 2);
            asm volatile("" : "+v"(aoff), "+v"(boff));
            if constexpr (HOOK) { if (t == nt / 2) { const int t3 = fresh_tid(wv);
                const int w3 = wv, l3 = t3 & 63; E.mid(acc, cur, w3 >> 2, w3 & 3, l3 & 15, l3 >> 4); } }
            const char* a1 = cA + (size_t)(t + 1) * kstep;
            const char* a2 = last ? nA : cA + (size_t)(t + 2) * kstep; const char* b2 = last ? nB : cB + (size_t)(t + 2) * kstep;
            const char* a3 = a2 + kstep; const char* b3 = b2 + kstep;
            PG8_LDB(B0, 0, 0); PG8_LDB(B1, 0, 1); PG8_SCHED; PG8_LDA(At, 0, 0); PG8_STAGE(PG8_SA(1, 1), a1 + hA, PG8_OA(1));
            if constexpr (GATHER) { if (last && has_next) { const int t4 = fresh_tid(wv);
#pragma unroll
                for (int i = 0; i < 2; ++i) { int R, C; stage_rc(t4 * 16 + i * 8192, R, C);
#pragma unroll
                    for (int h = 0; h < 2; ++h) oc[h][i] = (S.a_row(nxt, R + h * HALF) * (unsigned)lda + (unsigned)C) * 2u; } } }
            PG8_WAIT_V(8); PG8_WAIT_L(0); PG8_BAR; PG8_MMA(0, 0, At, B0); PG8_MMA(0, 1, At, B1); PG8_BAR; PG8_SCHED;
            PG8_LDA(At, 0, 1); PG8_STAGE(PG8_SB(0, 0), b2, voffB); PG8_STAGE(PG8_SB(0, 1), b2 + hstepB, voffB); PG8_STAGE(PG8_SA(0, 0), a2, PG8_OA(0));
            PG8_WAIT_V(8); PG8_WAIT_L(0); PG8_BAR; PG8_MMA(1, 0, At, B0); PG8_MMA(1, 1, At, B1); PG8_BAR; PG8_SCHED;
            PG8_LDB(B0, 1, 0); PG8_LDB(B1, 1, 1); PG8_SCHED; PG8_LDA(At, 1, 0); PG8_STAGE(PG8_SA(0, 1), a2 + hA, PG8_OA(1));
            PG8_WAIT_V(8); PG8_WAIT_L(0); PG8_BAR; PG8_MMA(0, 0, At, B0); PG8_MMA(0, 1, At, B1); PG8_BAR; PG8_SCHED;
            PG8_LDA(At, 1, 1); PG8_STAGE(PG8_SB(1, 0), b3, voffB); PG8_STAGE(PG8_SB(1, 1), b3 + hstepB, voffB); PG8_STAGE(PG8_SA(1, 0), a3, PG8_OA(0));
            PG8_WAIT_V(8); PG8_WAIT_L(0); PG8_BAR; PG8_MMA(1, 0, At, B0); PG8_MMA(1, 1, At, B1); PG8_BAR; PG8_SCHED;
        }
        if (wr == 0) PG8_BAR;
        { const int t2 = fresh_tid(wv);
          const int w2 = wv, l2 = t2 & 63; E(acc, cur, w2 >> 2, w2 & 3, l2 & 15, l2 >> 4); }
        if (!has_next) break;
#pragma unroll
        for (int a = 0; a < 2; ++a)
#pragma unroll
            for (int b = 0; b < 2; ++b)
#pragma unroll
                for (int m = 0; m < 4; ++m)
#pragma unroll
                    for (int n = 0; n < 2; ++n) acc[a][b][m][n] = (f32x4){0.f, 0.f, 0.f, 0.f};
        cur = nxt; cA = nA; cB = nB; ++ui;
        if (wr == 1) PG8_BAR;
    }
    PG8_WAIT_V(0);
    PG8_BAR;
#undef PG8_OA
#undef PG8_SA
#undef PG8_SB
#undef PG8_STAGE
#undef PG8_LDA
#undef PG8_LDB
#undef PG8_MMA
#undef PG8_CAT8
#undef PG8_WAIT_V
#undef PG8_WAIT_L
#undef PG8_BAR
#undef PG8_SCHED
}
}
constexpr size_t MiB = 1u << 20;
constexpr size_t WS_CTL = 0, CTL_ZERO_BYTES = 1 * MiB;
constexpr size_t WS_MOD = 1 * MiB;
constexpr size_t WS_WIN = 2 * MiB;
constexpr size_t WS_WBS = 13 * MiB, WS_WBH = 14 * MiB;
constexpr size_t WS_WO = 15 * MiB;
constexpr size_t WS_WGU = 18 * MiB;
constexpr size_t WS_WD = 83 * MiB;
constexpr size_t WS_PROJ = 116 * MiB;
constexpr size_t WS_GATES = 340 * MiB;
constexpr size_t WS_HGL = 468 * MiB;
constexpr size_t WS_HGG = 484 * MiB;
constexpr size_t WS_MERGED = 116 * MiB;
constexpr size_t WS_H2 = 180 * MiB;
constexpr size_t WS_ACT = 244 * MiB;
constexpr size_t WS_XMID = 324 * MiB;
constexpr size_t WS_LIST = 404 * MiB;
constexpr size_t WS_Y0 = 2 * MiB, WS_Y1 = 116 * MiB, WS_Y2 = 180 * MiB, WS_Y3 = 436 * MiB;
constexpr size_t WS_YS0 = 66 * MiB, WS_YS1 = 420 * MiB;
constexpr size_t WS_WRT = 500 * MiB;
constexpr size_t WS_DUMP = 510 * MiB;
constexpr size_t WS_END = 512 * MiB;
constexpr int ACT_SHARED_ROW0 = 262144 + 128 * 255 + 1;
constexpr int ACT_SH0 = ((ACT_SHARED_ROW0 + 255) / 256) * 256;
static_assert((size_t)(ACT_SH0 + T) * 256 <= 80 * MiB, "act region");
constexpr int CW_FAIL = 2;
constexpr int CW_BAR = 4096;
constexpr int CW_CNT = 16384;
constexpr int RING_BYTES = 131072;
constexpr int LDSCTL_OFF = 143360, MISC_OFF = LDSCTL_OFF + 320;
constexpr int TAB_OFF = LDSCTL_OFF + 1024;
constexpr int EPI_STG_OFF = 147456;
constexpr int LDS_BYTES = 163840;

#define XB_TMO      128
#define XB_XCNT(j)  (256  + 64 * (j))
#define XB_XSUB(j)  (1280 + 64 * (j))
#define XB_XGEN(j)  (2304 + 64 * (j))
#define XB_TOP      3328
#define XB_TOPGEN   3392
#define XCD_BAR_WORDS 3456
#define XB_SPIN_CAP (1u << 18)
__device__ __forceinline__ unsigned xb_ld(unsigned* p)              { return __hip_atomic_load(p, __ATOMIC_RELAXED, __HIP_MEMORY_SCOPE_AGENT); }
__device__ __forceinline__ unsigned xb_add(unsigned* p, unsigned v) { return __hip_atomic_fetch_add(p, v, __ATOMIC_RELAXED, __HIP_MEMORY_SCOPE_AGENT); }
__device__ __forceinline__ unsigned xb_xcc_id() { return (unsigned)__builtin_amdgcn_s_getreg((3 << 11) | 20) & 0xFu; }
#define XB_SPIN(cond, bar) do { unsigned _sp = 0; while (cond) { __builtin_amdgcn_s_sleep(1); \
    if ((++_sp & 255u) == 0u) { if (xb_ld(&(bar)[XB_TMO])) break; if (_sp > XB_SPIN_CAP) { atomicAdd(&(bar)[XB_TMO], 1u); break; } } } } while (0)
struct XcdBarrier { unsigned* bar; unsigned x; volatile LAS unsigned* st; int wv; };
__device__ __forceinline__ XcdBarrier xcd_barrier_post(unsigned* bar, volatile LAS unsigned* st, int wv) {
    XcdBarrier b; b.bar = bar; b.x = xb_xcc_id(); b.st = st; b.wv = wv;
    if (wv == 0 && fresh_lane() == 0) (void)xb_add(&bar[XB_XCNT(b.x)], 1u);
    return b;
}
__device__ __forceinline__ void xcd_barrier_complete(unsigned* bar, unsigned x, unsigned& nloc, unsigned& nx) {
    const unsigned G = gridDim.x * gridDim.y * gridDim.z;
    unsigned sum, cnt, mine, sp = 0u;
    for (;;) {
        sum = 0u; cnt = 0u; mine = 0u;
#pragma unroll
        for (unsigned j = 0; j < 16; ++j) { const unsigned c = xb_ld(&bar[XB_XCNT(j)]); sum += c; cnt += (c > 0u) ? 1u : 0u; mine = (j == x) ? c : mine; }
        if (sum == G) break;
        __builtin_amdgcn_s_sleep(1);
        if ((++sp & 255u) == 0u) { if (xb_ld(&bar[XB_TMO])) break; if (sp > XB_SPIN_CAP) { atomicAdd(&bar[XB_TMO], 1u); break; } }
    }
    nloc = mine > 0u ? mine : 1u; nx = cnt > 0u ? cnt : 1u;
}
__device__ __forceinline__ void xcd_barrier(const XcdBarrier& b) {
    asm volatile("s_waitcnt vmcnt(0)" ::: "memory");
    __syncthreads();
    if (b.wv == 0 && fresh_lane() == 0) {
        unsigned* bar = b.bar;
        __builtin_amdgcn_s_waitcnt(0);
        unsigned nloc = b.st[0], nx = b.st[1];
        if (nloc == 0u) { xcd_barrier_complete(bar, b.x, nloc, nx); b.st[0] = nloc; b.st[1] = nx; }
        const unsigned old = xb_add(&bar[XB_XSUB(b.x)], 1u);
        const unsigned gen = old / nloc;
        if (old + 1u == (gen + 1u) * nloc) {
            __builtin_amdgcn_fence(__ATOMIC_RELEASE, "agent");
            asm volatile("s_waitcnt vmcnt(0)" ::: "memory");
            const unsigned og = xb_add(&bar[XB_TOP], 1u);
            const unsigned tg = og / nx;
            if (og + 1u == (tg + 1u) * nx) xb_add(&bar[XB_TOPGEN], 1u);
            else XB_SPIN((int)(xb_ld(&bar[XB_TOPGEN]) - tg) <= 0, bar);
            __builtin_amdgcn_fence(__ATOMIC_ACQUIRE, "agent");
            xb_add(&bar[XB_XGEN(b.x)], 1u);
            asm volatile("s_waitcnt vmcnt(0)" ::: "memory");
        } else {
            XB_SPIN((int)(xb_ld(&bar[XB_XGEN(b.x)]) - gen) <= 0, bar);
            __builtin_amdgcn_fence(__ATOMIC_ACQUIRE, "agent");
            asm volatile("s_waitcnt vmcnt(0)" ::: "memory");
        }
    }
    __syncthreads();
}

__device__ __forceinline__ void xcd_arrive(const XcdBarrier& b) {
    asm volatile("s_waitcnt vmcnt(0)" ::: "memory");
    __syncthreads();
    if (b.wv == 0 && fresh_lane() == 0) {
        unsigned* bar = b.bar;
        __builtin_amdgcn_s_waitcnt(0);
        unsigned nloc = b.st[0], nx = b.st[1];
        if (nloc == 0u) { xcd_barrier_complete(bar, b.x, nloc, nx); b.st[0] = nloc; b.st[1] = nx; }
        const unsigned old = xb_add(&bar[XB_XSUB(b.x)], 1u);
        const unsigned gen = old / nloc;
        unsigned last = 0u;
        if (old + 1u == (gen + 1u) * nloc) {
            __builtin_amdgcn_fence(__ATOMIC_RELEASE, "agent");
            asm volatile("s_waitcnt vmcnt(0)" ::: "memory");
            const unsigned og = xb_add(&bar[XB_TOP], 1u);
            const unsigned tg = og / nx;
            if (og + 1u == (tg + 1u) * nx) xb_add(&bar[XB_TOPGEN], 1u);
            last = 1u;
        }
        b.st[2] = gen; b.st[3] = last;
    }
}
__device__ __forceinline__ void xcd_wait(const XcdBarrier& b) {
    if (b.wv == 0 && fresh_lane() == 0) {
        unsigned* bar = b.bar;
        const unsigned gen = b.st[2], last = b.st[3];
        XB_SPIN((int)(xb_ld(&bar[XB_TOPGEN]) - gen) <= 0, bar);
        __builtin_amdgcn_fence(__ATOMIC_ACQUIRE, "agent");
        if (last) xb_add(&bar[XB_XGEN(b.x)], 1u);
        asm volatile("s_waitcnt vmcnt(0)" ::: "memory");
    }
    __syncthreads();
}

struct Args {
    const float *x, *c, *w_ada, *b_ada, *norm1_g, *w_in, *sb_q_g, *sb_k_g, *hg_lb, *hg_norm_g, *w_br_sb, *w_br_hg, *w_out, *norm2_g, *w_router, *router_bias,
                *w_e_gate, *w_e_up, *w_e_down, *w_s_gate, *w_s_up, *w_s_down;
    float* out; unsigned char* ws; int ph_lo, ph_hi;
};
struct Frame {
    LAS unsigned char* lds; volatile LAS unsigned* MISC; gu32* ctl;
    int tid, lane, wave, vcu, G;
};
__device__ __forceinline__ float wave_sum(float v) {
#pragma unroll
    for (int o = 1; o < 64; o <<= 1) v += __shfl_xor(v, o);
    return v;
}

__device__ __forceinline__ void p0a_mod(Frame& F, const Args& a) {
    LAS float* cond = (LAS float*)F.lds;
    LAS float* red = (LAS float*)(F.lds + 32768);
    for (int i = F.tid; i < NB * D; i += 512) cond[i] = fsilu(a.c[i]);
    __syncthreads();
    float* mod = (float*)(a.ws + WS_MOD);
    for (int cb = blockIdx.x; cb < 6144 / 24; cb += F.G) {
        float acc[8];
#pragma unroll
        for (int b = 0; b < 8; ++b) acc[b] = 0.f;
        const int col = F.lane % 24, ksub = F.lane / 24;
        if (F.lane < 48) {
            for (int i = 0; i < 64; ++i) { const int k = 128 * F.wave + 2 * i + ksub; const float w = a.w_ada[(size_t)k * 6144 + cb * 24 + col];
#pragma unroll
                for (int b = 0; b < 8; ++b) acc[b] += cond[b * D + k] * w; }
#pragma unroll
            for (int b = 0; b < 8; ++b) red[((F.wave * 2 + ksub) * 24 + col) * 8 + b] = acc[b];
        }
        __syncthreads();
        if (F.tid < 192) { const int c2 = F.tid >> 3, b = F.tid & 7; float s = 0.f;
            for (int p = 0; p < 16; ++p) s += red[(p * 24 + c2) * 8 + b];
            mod[b * 6144 + cb * 24 + c2] = s + a.b_ada[cb * 24 + c2]; }
        __syncthreads();
    }
}

__device__ __forceinline__ float fp8_clamp(float x) { return __builtin_amdgcn_fmed3f(x, -440.f, 440.f); }
__device__ __forceinline__ unsigned pk4_fp8(float a, float b, float c, float d) { int r = __builtin_amdgcn_cvt_pk_fp8_f32(fp8_clamp(a), fp8_clamp(b), 0, false); r = __builtin_amdgcn_cvt_pk_fp8_f32(fp8_clamp(c), fp8_clamp(d), r, true); return (unsigned)r; }
constexpr float WBS_SCALE = 16.f, WO_SCALE = 32.f;
constexpr float WIN_SCALE = 32.f;
constexpr float WGU_SCALE = 32.f;
constexpr float WD_SCALE = 16.f, ACT_SCALE = 16.f, Y_SCALE = 16.f;
__device__ __forceinline__ void p0_tr_load(float (&v)[32], const float* W, int N, int item, int lane) {
    const int nblk = N / 32, kb = item / nblk, nb = item % nblk, k0 = 64 * kb, n0 = 32 * nb;
    const float* p = W + (size_t)(k0 + (lane >> 5)) * N + n0 + (lane & 31);
#pragma unroll
    for (int i = 0; i < 32; ++i) v[i] = __builtin_nontemporal_load(p + (size_t)(2 * i) * N);
}
__device__ __forceinline__ void p0_tr_finish(const float (&v)[32], int K, int N, bf16* WT, int row_off, int mode, int is_up, LAS float* scr, int item, int lane, int ldk = 0, int koff = 0, float f8scale = 0.f) {
    if (ldk == 0) ldk = K;
    const int nblk = N / 32, kb = item / nblk, nb = item % nblk, k0 = 64 * kb, n0 = 32 * nb;
#pragma unroll
    for (int i = 0; i < 32; ++i) { const int kk = 2 * i + (lane >> 5); scr[kk * 33 + (lane & 31)] = v[i]; }
    LDS_WAIT(); asm volatile("" ::: "memory");
    const int c = lane & 7;
#pragma unroll
    for (int j = 0; j < 4; ++j) { const int n = (lane >> 3) + 8 * j; const LAS float* s = scr + (8 * c) * 33 + n;
        v4u o; o.x = pk2(s[0 * 33], s[1 * 33]); o.y = pk2(s[2 * 33], s[3 * 33]); o.z = pk2(s[4 * 33], s[5 * 33]); o.w = pk2(s[6 * 33], s[7 * 33]);
        const int ng = n0 + n; const int drow = mode ? (row_off + 256 * (ng >> 7) + (ng & 127) + 128 * is_up) : (row_off + ng);
        if (f8scale != 0.f) { v2u o8; o8.x = pk4_fp8(s[0 * 33] * f8scale, s[1 * 33] * f8scale, s[2 * 33] * f8scale, s[3 * 33] * f8scale); o8.y = pk4_fp8(s[4 * 33] * f8scale, s[5 * 33] * f8scale, s[6 * 33] * f8scale, s[7 * 33] * f8scale);
            *(GAS v2u*)((unsigned char*)WT + (size_t)drow * ldk + koff + k0 + 8 * c) = o8; }
        else *(GAS v4u*)(WT + (size_t)drow * ldk + koff + k0 + 8 * c) = o; }
    LDS_WAIT(); asm volatile("" ::: "memory");
}
__device__ __forceinline__ void p0_transpose_item(const float* W, int K, int N, bf16* WT, int row_off, int mode, int is_up, LAS float* scr, int item, int lane, int ldk = 0, int koff = 0, float f8scale = 0.f) {
    float v[32]; p0_tr_load(v, W, N, item, lane); p0_tr_finish(v, K, N, WT, row_off, mode, is_up, scr, item, lane, ldk, koff, f8scale);
}
__device__ __forceinline__ void convert_expert_weights(Frame& F, const Args& a, LAS unsigned char* scr_base, const int k0, const int k1) {
    LAS float* scr = (LAS float*)(scr_base + F.wave * 8448);
    const int gw = F.vcu * 8 + F.wave, NGW = F.G * 8;
    bf16* WguT = (bf16*)(a.ws + WS_WGU); bf16* WdT = (bf16*)(a.ws + WS_WD);
    constexpr int I_GU = 16 * 8, I_DN = 4 * 32, I_E = 2 * I_GU + I_DN, NIT = 65 * I_E;
#define CEW_SRC(it, W, N, r) const float* W; int N, r; { const int e_ = (it) / I_E; r = (it) - e_ * I_E; \
        if (r < I_GU) { W = e_ < 64 ? a.w_e_gate + (size_t)e_ * D * EH : a.w_s_gate; N = EH; } \
        else if (r < 2 * I_GU) { r -= I_GU; W = e_ < 64 ? a.w_e_up + (size_t)e_ * D * EH : a.w_s_up; N = EH; } \
        else { r -= 2 * I_GU; W = e_ < 64 ? a.w_e_down + (size_t)e_ * EH * D : a.w_s_down; N = D; } }
    float nv[32];
    const int it0 = gw + k0 * NGW; int itE = gw + k1 * NGW; if (k1 < 0 || itE > NIT) itE = NIT;
    if (it0 < itE) { CEW_SRC(it0, W0, N0, r0) p0_tr_load(nv, W0, N0, r0, F.lane); }
    for (int it = it0; it < itE; it += NGW) {
        float cv[32];
#pragma unroll
        for (int i = 0; i < 32; ++i) cv[i] = nv[i];
        if (it + NGW < itE) { CEW_SRC(it + NGW, W1, N1, r1) p0_tr_load(nv, W1, N1, r1, F.lane); }
        const int e = it / I_E; int r = it - e * I_E;
        bf16* wgu8 = (bf16*)((unsigned char*)WguT + (size_t)e * 512 * D);
        if (r < I_GU) { p0_tr_finish(cv, D, EH, wgu8, 0, 1, 0, scr, r, F.lane, D, 0, WGU_SCALE); continue; } r -= I_GU;
        if (r < I_GU) { p0_tr_finish(cv, D, EH, wgu8, 0, 1, 1, scr, r, F.lane, D, 0, WGU_SCALE); continue; } r -= I_GU;
        p0_tr_finish(cv, EH, D, (bf16*)((unsigned char*)WdT + (size_t)e * D * EH), 0, 0, 0, scr, r, F.lane, EH, 0, WD_SCALE);
    }
#undef CEW_SRC
}
__device__ __forceinline__ void p0b_prologue(Frame& F, const Args& a, const XcdBarrier& wbar, const bool wsplit) {
    LAS float* scr = (LAS float*)(F.lds + F.wave * 16384);
    const int gw = F.vcu * 8 + F.wave, NGW = F.G * 8;
    bf16* WinT = (bf16*)(a.ws + WS_WIN); bf16* WbsT = (bf16*)(a.ws + WS_WBS); bf16* WoT = (bf16*)(a.ws + WS_WO);
    constexpr int I_IN = 16 * (NIN / 32), I_BR = 8 * 32, I_O = 16 * 32;
    constexpr int NITEMS = I_IN + 2 * I_BR + I_O;
    for (int it = gw; it < NITEMS; it += NGW) {
        int r = it;
        if (r < I_IN) { p0_transpose_item(a.w_in, D, NIN, WinT, 0, 0, 0, scr, r, F.lane, D, 0, WIN_SCALE); continue; } r -= I_IN;
        if (r < I_BR) { p0_transpose_item(a.w_br_sb, 512, D, WbsT, 0, 0, 0, scr, r, F.lane, 1024, 0, WBS_SCALE); continue; } r -= I_BR;
        if (r < I_BR) { p0_transpose_item(a.w_br_hg, 512, D, WbsT, 0, 0, 0, scr, r, F.lane, 1024, 512, WBS_SCALE); continue; } r -= I_BR;
        p0_transpose_item(a.w_out, D, D, WoT, 0, 0, 0, scr, r, F.lane, D, 0, WO_SCALE);
    }
    { v4u* WH = (v4u*)(a.ws + WS_WRT); v4u* WL = WH + 8 * 16 * 64;
      for (int f = F.vcu * 512 + F.tid; f < 8 * 16 * 64; f += F.G * 512) { const int ln = f & 63, q = (f >> 6) & 15, wv_ = f >> 10; const int n = ln & 15, kq = ln >> 4, ks = q >> 2, nb = q & 3;
          const float* wp = a.w_router + (size_t)(128 * wv_ + 32 * ks + 8 * kq) * 64 + 16 * nb + n; float fv[8];
#pragma unroll
          for (int j = 0; j < 8; ++j) fv[j] = wp[j * 64];
          v4u h, l;
          h.x = pg8::cvt_pk_bf16(fv[0], fv[1]); h.y = pg8::cvt_pk_bf16(fv[2], fv[3]); h.z = pg8::cvt_pk_bf16(fv[4], fv[5]); h.w = pg8::cvt_pk_bf16(fv[6], fv[7]);
          l.x = pg8::cvt_pk_bf16(fv[0] - bflo(h.x), fv[1] - bfhi(h.x)); l.y = pg8::cvt_pk_bf16(fv[2] - bflo(h.y), fv[3] - bfhi(h.y)); l.z = pg8::cvt_pk_bf16(fv[4] - bflo(h.z), fv[5] - bfhi(h.z)); l.w = pg8::cvt_pk_bf16(fv[6] - bflo(h.w), fv[7] - bfhi(h.w));
          WH[f] = h; WL[f] = l; } }
    if (wsplit) xcd_wait(wbar);
    const float* mod = (const float*)(a.ws + WS_MOD);
    unsigned char* H = (unsigned char*)a.out + 64 * MiB;
    f32x4 nv[4];
    if (gw < T) { const GAS f32x4* xr = (const GAS f32x4*)(a.x + (size_t)gw * D) + F.lane;
#pragma unroll
        for (int j = 0; j < 4; ++j) nv[j] = __builtin_nontemporal_load(xr + 64 * j); }
    f32x4 g1v[4];
#pragma unroll
    for (int j = 0; j < 4; ++j) g1v[j] = *(const f32x4*)(a.norm1_g + 4 * F.lane + 256 * j);
    for (int m = gw; m < T; m += NGW) {
        const int b = m >> 12;
        f32x4 v[4], shv[4], scv[4]; float s2 = 0.f;
#pragma unroll
        for (int j = 0; j < 4; ++j) { const int c0 = 4 * F.lane + 256 * j; shv[j] = *(const f32x4*)(mod + b * 6144 + c0); scv[j] = *(const f32x4*)(mod + b * 6144 + 1024 + c0); }
#pragma unroll
        for (int j = 0; j < 4; ++j) { v[j] = nv[j]; s2 += (v[j].x * v[j].x + v[j].y * v[j].y) + (v[j].z * v[j].z + v[j].w * v[j].w); }
        if (m + NGW < T) { const GAS f32x4* xr = (const GAS f32x4*)(a.x + (size_t)(m + NGW) * D) + F.lane;
#pragma unroll
            for (int j = 0; j < 4; ++j) nv[j] = __builtin_nontemporal_load(xr + 64 * j); }
        const float rstd = __builtin_amdgcn_rsqf(wave_sum(s2) * (1.f / D) + EPS);
        GAS unsigned* o8 = (GAS unsigned*)(H + (size_t)m * D) + F.lane;
#pragma unroll
        for (int j = 0; j < 4; ++j) { const f32x4 y = v[j] * rstd * g1v[j] * (scv[j] + 1.0f) + shv[j];
            o8[64 * j] = pk4_fp8(y.x, y.y, y.z, y.w); }
    }
}

struct SchedDense {
    pg8::DenseOrder O; const char* A; const char* B; int lda, ldb;
    __device__ __forceinline__ bool next(int i, pg8::Unit& u) const { int pm, pn; if (!O.tile(i, pm, pn)) return false; u.pm = pm; u.pn = pn; u.z = 0; u.r0 = 0; u.nr = 256; u.ar = 0; return true; }
    __device__ __forceinline__ const char* a_base(const pg8::Unit& u) const { return A + (size_t)u.pm * 256 * lda * 2; }
    __device__ __forceinline__ const char* b_base(const pg8::Unit& u) const { return B + (size_t)u.pn * 256 * ldb * 2; }
    __device__ __forceinline__ unsigned a_row(const pg8::Unit&, int) const { return 0u; }
};
struct EpiProj {
    static constexpr int PERM = 2;
    bf16* proj; unsigned char* gates; LAS unsigned char* stg; int shadow;
    __device__ __forceinline__ void operator()(const f32x4 (&acc)[2][2][4][2], const pg8::Unit& u, int wr, int wc, int fr, int fq) const {
#ifdef PROBE_NOEPI
        if (shadow) return;
#endif
        constexpr float IS = 1.f / WIN_SCALE;
        if (u.pn < 14) {
            LAS unsigned char* sw = stg + (wr * 4 + wc) * 2048;
            const int l = fq * 16 + fr, rr = l >> 3, ch = l & 7;
            bf16* gp = proj + ((size_t)(u.pm * 16 + wr * 4) * 56 + (u.pn * 4 + wc)) * 1024 + l * 8;
#pragma unroll
            for (int ai = 0; ai < 2; ++ai)
#pragma unroll
                for (int m = 0; m < 4; ++m) {
                    const f32x4 v0 = acc[ai][0][m][0] * IS, v1 = acc[ai][0][m][1] * IS, v2 = acc[ai][1][m][0] * IS, v3 = acc[ai][1][m][1] * IS;
                    v4u w0, w1; w0.x = pg8::cvt_pk_bf16(v0[0], v0[1]); w0.y = pg8::cvt_pk_bf16(v0[2], v0[3]); w0.z = pg8::cvt_pk_bf16(v1[0], v1[1]); w0.w = pg8::cvt_pk_bf16(v1[2], v1[3]);
                    w1.x = pg8::cvt_pk_bf16(v2[0], v2[1]); w1.y = pg8::cvt_pk_bf16(v2[2], v2[3]); w1.z = pg8::cvt_pk_bf16(v3[0], v3[1]); w1.w = pg8::cvt_pk_bf16(v3[2], v3[3]);
                    *(LAS v4u*)(sw + fr * 128 + fq * 32) = w0; *(LAS v4u*)(sw + fr * 128 + fq * 32 + 16) = w1;
                    asm volatile("s_waitcnt lgkmcnt(0)" ::: "memory");
                    const v4u r0 = *(const LAS v4u*)(sw + rr * 128 + ch * 16), r1 = *(const LAS v4u*)(sw + (rr + 8) * 128 + ch * 16);
                    bf16* bp = gp + (size_t)(ai * 8 + m) * 56 * 1024;
                    __builtin_nontemporal_store(r0, (v4u*)bp); __builtin_nontemporal_store(r1, (v4u*)(bp + 512)); }
        } else {
            const int row0 = u.pm * 256 + wr * 64 + fr, col0 = (u.pn - 14) * 256 + wc * 64 + 16 * fq;
#pragma unroll
            for (int ai = 0; ai < 2; ++ai)
#pragma unroll
                for (int m = 0; m < 4; ++m) { unsigned char* rowp = gates + (size_t)(row0 + ai * 128 + m * 16) * NG + col0;
                    const f32x4 v0 = acc[ai][0][m][0] * IS, v1 = acc[ai][0][m][1] * IS, v2 = acc[ai][1][m][0] * IS, v3 = acc[ai][1][m][1] * IS;
                    v4u w; w.x = pk4_fp8(v0[0], v0[1], v0[2], v0[3]); w.y = pk4_fp8(v1[0], v1[1], v1[2], v1[3]); w.z = pk4_fp8(v2[0], v2[1], v2[2], v2[3]); w.w = pk4_fp8(v3[0], v3[1], v3[2], v3[3]);
                    __builtin_nontemporal_store(w, (v4u*)rowp); }
        }
    }
};
namespace sba {
typedef float f32x2_t __attribute__((ext_vector_type(2))); typedef __bf16 bf16x2_t __attribute__((ext_vector_type(2)));
__device__ __forceinline__ unsigned cvtpk(float lo, float hi) { f32x2_t v = {lo, hi}; bf16x2_t b = __builtin_convertvector(v, bf16x2_t); return __builtin_bit_cast(unsigned, b); }
__device__ __forceinline__ int crow(int r, int hi) { return (r & 3) + 8 * (r >> 2) + 4 * hi; }
constexpr int LK = 0, LV = 16384, LFLAG = 32768, LOST = 33024;
constexpr float DONE_THR = 9.0949470e-13f;

struct TileRegs { v4u k, v; };
__device__ __forceinline__ void tile_load(TileRegs& R, const bf16* proj, int b, int h, int kb, int tid) {
    const int key = tid >> 3, ch = tid & 7; const size_t row = (size_t)(b * SEQ + kb + key);
    R.k = *(const v4u*)(proj + proj_at(row, COL_K + h * 64 + ch * 8)); R.v = *(const v4u*)(proj + proj_at(row, COL_V + h * 64 + ch * 8));
}
__device__ __forceinline__ void tile_store(const TileRegs& R, LAS unsigned char* lds, int buf, const float (&gk)[8], int tid) {
    const int key = tid >> 3, ch = tid & 7;
    float v[8]; v[0] = bflo(R.k.x); v[1] = bfhi(R.k.x); v[2] = bflo(R.k.y); v[3] = bfhi(R.k.y); v[4] = bflo(R.k.z); v[5] = bfhi(R.k.z); v[6] = bflo(R.k.w); v[7] = bfhi(R.k.w);
    float ss = 0.f;
#pragma unroll
    for (int i = 0; i < 8; ++i) ss += v[i] * v[i];
    ss += __builtin_bit_cast(float, __builtin_amdgcn_update_dpp(0, __builtin_bit_cast(int, ss), 0xB1, 0xF, 0xF, false));
    ss += __builtin_bit_cast(float, __builtin_amdgcn_update_dpp(0, __builtin_bit_cast(int, ss), 0x4E, 0xF, 0xF, false));
    ss += __builtin_bit_cast(float, __builtin_amdgcn_update_dpp(0, __builtin_bit_cast(int, ss), 0x141, 0xF, 0xF, false));
    const float rstd = __builtin_amdgcn_rsqf(ss * (1.f / 64.f) + EPS);
    v4u o; o.x = cvtpk(v[0] * rstd * gk[0], v[1] * rstd * gk[1]); o.y = cvtpk(v[2] * rstd * gk[2], v[3] * rstd * gk[3]); o.z = cvtpk(v[4] * rstd * gk[4], v[5] * rstd * gk[5]); o.w = cvtpk(v[6] * rstd * gk[6], v[7] * rstd * gk[7]);
    *(LAS v4u*)(lds + buf * 16384 + key * 128 + ((ch ^ (key & 7)) << 4)) = o;
    *(LAS v4u*)(lds + buf * 16384 + 8192 + (ch >> 2) * 4096 + key * 64 + (ch & 3) * 16) = R.v;
}

__device__ __forceinline__ void attn_unit(const Args& a, int b, int h, int qblk, LAS unsigned char* lds, const int wv) {
    const int tid = fresh_tid(wv), lane = tid & 63, r32 = lane & 31, hi = lane >> 5; const int wid = wv;
    const bf16* proj = (const bf16*)(a.ws + WS_PROJ);
    unsigned char* obuf = (unsigned char*)a.out;
    const int q0 = qblk * 256, qw = q0 + wid * 32;
    float gk[8];
#pragma unroll
    for (int i = 0; i < 8; ++i) gk[i] = a.sb_k_g[(lane & 7) * 8 + i];
    bf16x8 qr[4];
    {
        const bf16* qrow = proj + proj_at((size_t)(b * SEQ + qw + r32), COL_Q + h * 64 + hi * 8);
        v4u raw[4]; float ss = 0.f;
#pragma unroll
        for (int d0 = 0; d0 < 4; ++d0) { raw[d0] = *(const v4u*)(qrow + d0 * 16);
            const float x0 = bflo(raw[d0].x), x1 = bfhi(raw[d0].x), x2 = bflo(raw[d0].y), x3 = bfhi(raw[d0].y), x4 = bflo(raw[d0].z), x5 = bfhi(raw[d0].z), x6 = bflo(raw[d0].w), x7 = bfhi(raw[d0].w);
            ss += (x0 * x0 + x1 * x1) + (x2 * x2 + x3 * x3) + (x4 * x4 + x5 * x5) + (x6 * x6 + x7 * x7); }
        ss += __shfl_xor(ss, 32);
        const float rs = 0.125f / sqrtf(ss * (1.f / 64.f) + EPS);
#pragma unroll
        for (int d0 = 0; d0 < 4; ++d0) { const float* g = a.sb_q_g + d0 * 16 + hi * 8;
            v4u o; o.x = cvtpk(bflo(raw[d0].x) * rs * g[0], bfhi(raw[d0].x) * rs * g[1]); o.y = cvtpk(bflo(raw[d0].y) * rs * g[2], bfhi(raw[d0].y) * rs * g[3]);
            o.z = cvtpk(bflo(raw[d0].z) * rs * g[4], bfhi(raw[d0].z) * rs * g[5]); o.w = cvtpk(bflo(raw[d0].w) * rs * g[6], bfhi(raw[d0].w) * rs * g[7]);
            qr[d0] = __builtin_bit_cast(bf16x8, o); }
    }
    f32x16 o0 = {}, o1 = {};
    float carry = 1.f; bool done = false;
    const int i16 = lane & 15;
    const int vlane = ((lane >> 4) & 1) * 32 + (i16 & 3) * 8 + (4 * hi + (i16 >> 2)) * 64;
    for (int jt = (qw + 31) >> 6; jt >= 0; --jt) {
        const int kb = 64 * jt;
        { TileRegs R[8];
#pragma unroll
          for (int j = 0; j < 8; ++j) tile_load(R[j], proj, b, h, kb, 64 * j + lane);
#pragma unroll
          for (int j = 0; j < 8; ++j) tile_store(R[j], lds, wid, gk, 64 * j + lane); }
        {
            const LAS unsigned char* Kb = lds + wid * 16384; const LAS unsigned char* Vb = Kb + 8192;
            f32x16 p0 = {}, p1 = {};
            __builtin_amdgcn_s_setprio(1);
#pragma unroll
            for (int d0 = 0; d0 < 4; ++d0) {
                const int c = 2 * d0 + hi;
                const bf16x8 k0 = *(const LAS bf16x8*)(Kb + r32 * 128 + ((c ^ (r32 & 7)) << 4));
                const bf16x8 k1 = *(const LAS bf16x8*)(Kb + (32 + r32) * 128 + ((c ^ (r32 & 7)) << 4));
                p0 = __builtin_amdgcn_mfma_f32_32x32x16_bf16(k0, qr[d0], p0, 0, 0, 0);
                p1 = __builtin_amdgcn_mfma_f32_32x32x16_bf16(k1, qr[d0], p1, 0, 0, 0);
            }
            __builtin_amdgcn_s_setprio(0);
            const int qrel = qw + r32 - kb;
            const bool need_mask = (kb + 63 >= qw);
            float R0[16], R1[16];
#pragma unroll
            for (int r = 0; r < 16; ++r) {
                const int k0i = crow(r, hi), k1i = 32 + k0i;
                const float e0 = __expf(fminf(p0[r], 80.f)), e1 = __expf(fminf(p1[r], 80.f));
                float r0 = __builtin_amdgcn_rcpf(1.0f + e0), r1 = __builtin_amdgcn_rcpf(1.0f + e1);
                float b0 = e0 * r0, b1 = e1 * r1;
                if (need_mask) { if (k0i >= qrel) { r0 = 1.f; b0 = 0.f; } if (k1i >= qrel) { r1 = 1.f; b1 = 0.f; } }
                R0[r] = r0; R1[r] = r1; p0[r] = b0; p1[r] = b1;
            }
            float gs[8], pg[8];
#pragma unroll
            for (int g = 0; g < 4; ++g) { gs[g] = (R0[4 * g] * R0[4 * g + 1]) * (R0[4 * g + 2] * R0[4 * g + 3]); gs[4 + g] = (R1[4 * g] * R1[4 * g + 1]) * (R1[4 * g + 2] * R1[4 * g + 3]); }
#pragma unroll
            for (int g = 0; g < 8; ++g) pg[g] = __shfl_xor(gs[g], 32);
            float run = carry;
#pragma unroll
            for (int idx = 7; idx >= 0; --idx) {
                const int g = idx & 3;
                float e = hi == 0 ? run * pg[idx] : run;
                if (idx >= 4) {
#pragma unroll
                    for (int i = 3; i >= 0; --i) { const int r = 4 * g + i; p1[r] *= e; e *= R1[r]; }
                } else {
#pragma unroll
                    for (int i = 3; i >= 0; --i) { const int r = 4 * g + i; p0[r] *= e; e *= R0[r]; }
                }
                run *= gs[idx] * pg[idx];
            }
            carry = run;
            __builtin_amdgcn_s_setprio(1);
#pragma unroll
            for (int kk = 0; kk < 4; ++kk) {
                v4u pw;
                if (kk == 0)      { pw.x = cvtpk(p0[0], p0[1]);  pw.y = cvtpk(p0[2], p0[3]);   pw.z = cvtpk(p0[4], p0[5]);   pw.w = cvtpk(p0[6], p0[7]); }
                else if (kk == 1) { pw.x = cvtpk(p0[8], p0[9]);  pw.y = cvtpk(p0[10], p0[11]); pw.z = cvtpk(p0[12], p0[13]); pw.w = cvtpk(p0[14], p0[15]); }
                else if (kk == 2) { pw.x = cvtpk(p1[0], p1[1]);  pw.y = cvtpk(p1[2], p1[3]);   pw.z = cvtpk(p1[4], p1[5]);   pw.w = cvtpk(p1[6], p1[7]); }
                else              { pw.x = cvtpk(p1[8], p1[9]);  pw.y = cvtpk(p1[10], p1[11]); pw.z = cvtpk(p1[12], p1[13]); pw.w = cvtpk(p1[14], p1[15]); }
                const bf16x8 pa = __builtin_bit_cast(bf16x8, pw);
                const LAS unsigned char* vp = Vb + kk * 1024 + vlane;
                const s16x4 a0 = __builtin_bit_cast(s16x4, __builtin_amdgcn_ds_read_tr16_b64_v4i16((LAS s16x4*)(vp)));
                const s16x4 a1 = __builtin_bit_cast(s16x4, __builtin_amdgcn_ds_read_tr16_b64_v4i16((LAS s16x4*)(vp + 512)));
                const s16x4 b0 = __builtin_bit_cast(s16x4, __builtin_amdgcn_ds_read_tr16_b64_v4i16((LAS s16x4*)(vp + 4096)));
                const s16x4 b1 = __builtin_bit_cast(s16x4, __builtin_amdgcn_ds_read_tr16_b64_v4i16((LAS s16x4*)(vp + 4096 + 512)));
                const bf16x8 vf0 = __builtin_shufflevector(a0, a1, 0, 1, 2, 3, 4, 5, 6, 7), vf1 = __builtin_shufflevector(b0, b1, 0, 1, 2, 3, 4, 5, 6, 7);
                o0 = __builtin_amdgcn_mfma_f32_32x32x16_bf16(pa, vf0, o0, 0, 0, 0);
                o1 = __builtin_amdgcn_mfma_f32_32x32x16_bf16(pa, vf1, o1, 0, 0, 0);
            }
            __builtin_amdgcn_s_setprio(0);
            done = __all(carry < DONE_THR);
        }
        if (done) break;
    }
    {
        LAS unsigned char* stg = lds + wid * 16384;
#pragma unroll
        for (int r = 0; r < 16; ++r) { const int q = crow(r, hi); const unsigned pk = (unsigned)__builtin_amdgcn_cvt_pk_fp8_f32(fp8_clamp(o0[r]), fp8_clamp(o1[r]), 0, false);
            *(LAS unsigned char*)(stg + q * 64 + r32) = (unsigned char)(pk & 0xFFu); *(LAS unsigned char*)(stg + q * 64 + 32 + r32) = (unsigned char)((pk >> 8) & 0xFFu); }
        asm volatile("s_waitcnt lgkmcnt(0)" ::: "memory");
        unsigned char* orow = obuf + (size_t)(b * SEQ + qw) * 1024 + h * 64;
#pragma unroll
        for (int i = 0; i < 2; ++i) { const int row = i * 16 + (lane >> 2), ch = lane & 3; const v4u v = *(const LAS v4u*)(stg + row * 64 + ch * 16); *(v4u*)(orow + (size_t)row * 1024 + ch * 16) = v; }
    }
}
}
namespace hg {
constexpr int RS128 = 272, RS64 = 144;
constexpr int L_KH = 0, L_QH = 17408, L_RG = 34816, L_KT = 52224, L_VT = 70656, L_PP = 89088, L_ST = 98304, L_TOT = 133120, L_SS = 141312;
static_assert(L_SS + 512 <= LDSCTL_OFF, "HGRN2 LDS map");
__device__ __forceinline__ f32x4 mma16(const LAS unsigned char* A, int ars, const LAS unsigned char* B, int brs, int ksteps, int lane, f32x4 acc) {
    const int r = lane & 15, kq = lane >> 4;
#pragma unroll 4
    for (int ks = 0; ks < ksteps; ++ks) {
        const bf16x8 av = *(const LAS bf16x8*)(A + r * ars + (32 * ks + 8 * kq) * 2);
        const bf16x8 bv = *(const LAS bf16x8*)(B + r * brs + (32 * ks + 8 * kq) * 2);
        acc = __builtin_amdgcn_mfma_f32_16x16x32_bf16(av, bv, acc, 0, 0, 0);
    }
    return acc;
}
#define HG_BAR() do { asm volatile("s_waitcnt lgkmcnt(0)" ::: "memory"); __builtin_amdgcn_s_barrier(); asm volatile("" ::: "memory"); } while (0)
__device__ __forceinline__ unsigned cvtpk(float lo, float hi) { return pg8::cvt_pk_bf16(lo, hi); }
__device__ __forceinline__ float ex2(float x) { return __builtin_amdgcn_exp2f(x); }
__device__ __forceinline__ float lg2(float x) { return __builtin_amdgcn_logf(x); }
template <bool FULL> struct Raw { v4u f[2], i[2], q[FULL ? 2 : 1], g[FULL ? 2 : 1]; };
template <bool FULL>
__device__ __forceinline__ void raw_load(Raw<FULL>& R, const bf16* proj, size_t t0, int h, int tid) {
    const size_t row = t0 + (tid >> 3); const int c = h * 128 + (tid & 7) * 8;
#pragma unroll
    for (int j = 0; j < 2; ++j) { R.f[j] = *(const v4u*)(proj + proj_at(row, COL_F + c + 64 * j)); R.i[j] = *(const v4u*)(proj + proj_at(row, COL_I + c + 64 * j));
        if constexpr (FULL) { R.q[j] = *(const v4u*)(proj + proj_at(row, COL_HQ + c + 64 * j)); R.g[j] = *(const v4u*)(proj + proj_at(row, COL_HG + c + 64 * j)); } }
}
template <bool FULL, int ABL = 0>
__device__ __forceinline__ void segment(const Args& a, int b, int h, int seg, LAS unsigned char* lds, const int wv) {
    const int tid = fresh_tid(wv), lane = tid & 63; const int w = wv;
    const bf16* proj = (const bf16*)(a.ws + WS_PROJ);
    unsigned char* obuf = (unsigned char*)a.out + (ABL ? (size_t)32 * 1024 * 1024 : 0);
    float* Lbuf = (float*)(a.ws + WS_HGL); float* Gbuf = (float*)(a.ws + WS_HGG);
    const int ubase = (b * 4 + h) * 8;
    const float lb0 = fsigmoid(a.hg_lb[h * 128 + 2 * lane] - a.hg_lb[512 + h * 128 + 2 * lane]), lb1 = fsigmoid(a.hg_lb[h * 128 + 2 * lane + 1] - a.hg_lb[512 + h * 128 + 2 * lane + 1]);
    const float om0 = 1.f - lb0, om1 = 1.f - lb1;
    LAS float* TOT = (LAS float*)(lds + L_TOT);
    LAS float* SS = (LAS float*)(lds + L_SS);
    const size_t tseg = (size_t)b * SEQ + seg * 512;
    Raw<FULL> R;
    raw_load<FULL>(R, proj, tseg, h, tid);
    f32x4 S[8]; float Gacc[4] = {0.f, 0.f, 0.f, 0.f};
#pragma unroll
    for (int ni = 0; ni < 8; ++ni) S[ni] = (f32x4){0.f, 0.f, 0.f, 0.f};
    const int dd0 = 16 * w + 4 * (lane >> 4), vl = lane & 15;
    if constexpr (FULL) {
        for (int i = 0; i < seg; ++i) {
            const float* Li = Lbuf + (size_t)(ubase + i) * 16384; const float* Gi = Gbuf + (ubase + i) * 128;
#pragma unroll
            for (int r = 0; r < 4; ++r) { const float eg = ex2(Gi[dd0 + r]);
#pragma unroll
                for (int ni = 0; ni < 8; ++ni) S[ni][r] = eg * S[ni][r] + Li[(dd0 + r) * 128 + 16 * ni + vl]; }
        }
    }
    const int sc = tid >> 3, sch = tid & 7;
    for (int n = 0; n < 8; ++n) {
        const int par = n & 1; const size_t t0 = tseg + n * 64;
#pragma unroll
        for (int j = 0; j < 2; ++j) { const int off = sc * RS128 + (sch * 8 + 64 * j) * 2;
            *(LAS v4u*)(lds + L_KH + off) = R.f[j]; *(LAS v4u*)(lds + L_RG + off) = R.i[j];
            if constexpr (FULL) *(LAS v4u*)(lds + L_QH + off) = R.q[j]; }
        v4u gkeep[2];
        if constexpr (FULL) { gkeep[0] = R.g[0]; gkeep[1] = R.g[1]; }
        if (n < 7) raw_load<FULL>(R, proj, t0 + 64, h, tid);
        HG_BAR();
        float cs0[8] = {}, cs1[8] = {}, kk0[8] = {}, kk1[8] = {}; float run0 = 0.f, run1 = 0.f;
#pragma unroll
        for (int i = 0; i < (ABL == 3 ? 0 : 8); ++i) { const unsigned fw = *(const LAS unsigned*)(lds + L_KH + (8 * w + i) * RS128 + lane * 4);
            const float s0 = fsigmoid(bflo(fw)), s1 = fsigmoid(bfhi(fw));
            run0 += lg2(lb0 + om0 * s0); run1 += lg2(lb1 + om1 * s1); cs0[i] = run0; cs1[i] = run1; kk0[i] = om0 - om0 * s0; kk1[i] = om1 - om1 * s1; }
        *(LAS f32x2v*)(TOT + (par * 8 + w) * 128 + 2 * lane) = (f32x2v){run0, run1};
        HG_BAR();
        {
            float off0 = 0.f, off1 = 0.f, gref0 = 0.f, gref1 = 0.f;
#pragma unroll
            for (int p = 0; p < 4; ++p) { const f32x2v t = *(const LAS f32x2v*)(TOT + (par * 8 + p) * 128 + 2 * lane); gref0 += t.x; gref1 += t.y; if (p < w) { off0 += t.x; off1 += t.y; } }
#pragma unroll
            for (int p = 4; p < 7; ++p) { if (p < w) { const f32x2v t = *(const LAS f32x2v*)(TOT + (par * 8 + p) * 128 + 2 * lane); off0 += t.x; off1 += t.y; } }
            unsigned kt0[4] = {}, kt1[4] = {}, vt0[4] = {}, vt1[4] = {};
#pragma unroll
            for (int i = 0; i < (ABL == 3 ? 0 : 8); i += 2) {
                float kh0[2], kh1[2]; unsigned iw[2];
#pragma unroll
                for (int j = 0; j < 2; ++j) { const int c = 8 * w + i + j;
                    const float e10 = ex2(cs0[i + j] + off0 - gref0), e11 = ex2(cs1[i + j] + off1 - gref1);
                    kh0[j] = kk0[i + j] * __builtin_amdgcn_rcpf(e10); kh1[j] = kk1[i + j] * __builtin_amdgcn_rcpf(e11);
                    *(LAS unsigned*)(lds + L_KH + c * RS128 + lane * 4) = cvtpk(kh0[j], kh1[j]);
                    if constexpr (FULL) { LAS unsigned* qp = (LAS unsigned*)(lds + L_QH + c * RS128 + lane * 4); const unsigned qw = *qp; *qp = cvtpk(fsilu(bflo(qw)) * e10, fsilu(bfhi(qw)) * e11); }
                    iw[j] = *(const LAS unsigned*)(lds + L_RG + c * RS128 + lane * 4); }
                kt0[i >> 1] = cvtpk(kh0[0], kh0[1]); kt1[i >> 1] = cvtpk(kh1[0], kh1[1]);
                vt0[i >> 1] = (iw[0] & 0xffffu) | (iw[1] << 16); vt1[i >> 1] = (iw[0] >> 16) | (iw[1] & 0xffff0000u);
            }
            *(LAS v4u*)(lds + L_KT + (2 * lane) * RS64 + w * 16) = (v4u){kt0[0], kt0[1], kt0[2], kt0[3]}; *(LAS v4u*)(lds + L_KT + (2 * lane + 1) * RS64 + w * 16) = (v4u){kt1[0], kt1[1], kt1[2], kt1[3]};
            *(LAS v4u*)(lds + L_VT + (2 * lane) * RS64 + w * 16) = (v4u){vt0[0], vt0[1], vt0[2], vt0[3]}; *(LAS v4u*)(lds + L_VT + (2 * lane + 1) * RS64 + w * 16) = (v4u){vt1[0], vt1[1], vt1[2], vt1[3]};
            if constexpr (FULL) {
                float eg[4];
#pragma unroll
                for (int r = 0; r < 4; ++r) { const LAS float* tp = TOT + par * 1024 + dd0 + r; eg[r] = ex2((tp[0] + tp[128]) + (tp[256] + tp[384])); }
#pragma unroll
                for (int ni = 0; ni < 8; ++ni) { v2u o; o.x = cvtpk(S[ni][0] * eg[0], S[ni][1] * eg[1]); o.y = cvtpk(S[ni][2] * eg[2], S[ni][3] * eg[3]);
                    *(LAS v2u*)(lds + L_ST + (16 * ni + vl) * RS128 + dd0 * 2) = o; }
            }
        }
        HG_BAR();
        if constexpr (FULL) {
#pragma unroll
            for (int j = 0; j < 2; ++j) *(LAS v4u*)(lds + L_RG + sc * RS128 + (sch * 8 + 64 * j) * 2) = gkeep[j];
        }
        if constexpr (FULL) {
            const int mi = w >> 1;
#pragma unroll
            for (int j = 0; j < 2; ++j) { const int ni = 2 * (w & 1) + j;
                f32x4 acc = (f32x4){0.f, 0.f, 0.f, 0.f};
                if (ABL != 2 && ni <= mi) acc = mma16(lds + L_QH + 16 * mi * RS128, RS128, lds + L_KH + 16 * ni * RS128, RS128, 4, lane, acc);
                const int s = 16 * ni + vl;
#pragma unroll
                for (int r = 0; r < 4; ++r) { const int c = 16 * mi + 4 * (lane >> 4) + r; *(LAS bf16*)(lds + L_PP + c * RS64 + s * 2) = (bf16)f2bf(s <= c ? acc[r] : 0.f); } }
            HG_BAR();
        }
        f32x4 oacc[4];
        if constexpr (FULL) {
            const int mi = w >> 1;
#pragma unroll
            for (int j = 0; j < 4; ++j) { const int ni = 4 * (w & 1) + j;
                f32x4 acc = (f32x4){0.f, 0.f, 0.f, 0.f};
                if constexpr (ABL != 2) { acc = mma16(lds + L_PP + 16 * mi * RS64, RS64, lds + L_VT + 16 * ni * RS64, RS64, 2, lane, acc);
                acc = mma16(lds + L_QH + 16 * mi * RS128, RS128, lds + L_ST + 16 * ni * RS128, RS128, 4, lane, acc); }
                oacc[j] = acc; }
        }
        {
            float egl[4], e1[4];
#pragma unroll
            for (int r = 0; r < 4; ++r) { const LAS float* tp = TOT + par * 1024 + dd0 + r; const float gr = (tp[0] + tp[128]) + (tp[256] + tp[384]), gl = gr + (tp[512] + tp[640]) + (tp[768] + tp[896]);
                egl[r] = ex2(gl); e1[r] = ex2(gl - gr); Gacc[r] += gl; }
#pragma unroll
            for (int ni = 0; ni < 8; ++ni) {
                f32x4 kv = (f32x4){0.f, 0.f, 0.f, 0.f};
                if constexpr (ABL != 2) kv = mma16(lds + L_KT + 16 * w * RS64, RS64, lds + L_VT + 16 * ni * RS64, RS64, 2, lane, kv);
#pragma unroll
                for (int r = 0; r < 4; ++r) S[ni][r] = egl[r] * S[ni][r] + e1[r] * kv[r];
            }
        }
        if constexpr (FULL && ABL != 1) {
            const int mi = w >> 1;
#pragma unroll
            for (int r = 0; r < 4; ++r) { float s = 0.f;
#pragma unroll
                for (int j = 0; j < 4; ++j) s += oacc[j][r] * oacc[j][r];
                s += __shfl_xor(s, 1); s += __shfl_xor(s, 2); s += __shfl_xor(s, 4); s += __shfl_xor(s, 8);
                if (vl == 0) SS[(16 * mi + 4 * (lane >> 4) + r) * 2 + (w & 1)] = s; }
            HG_BAR();
#pragma unroll
            for (int r = 0; r < 4; ++r) { const int c = 16 * mi + 4 * (lane >> 4) + r; const float rstd = __builtin_amdgcn_rsqf((SS[c * 2] + SS[c * 2 + 1]) * (1.f / 128.f) + EPS);
#pragma unroll
                for (int j = 0; j < 4; ++j) { const int v = 16 * (4 * (w & 1) + j) + vl;
                    const float g = bf2f(*(const LAS bf16*)(lds + L_RG + c * RS128 + v * 2));
                    *(LAS unsigned char*)(lds + L_QH + c * RS128 + v) = (unsigned char)((unsigned)__builtin_amdgcn_cvt_pk_fp8_f32(fp8_clamp(oacc[j][r] * rstd * a.hg_norm_g[v] * fsilu(g)), 0.f, 0, false) & 0xFFu); } }
            HG_BAR();
            { const v4u ov = *(const LAS v4u*)(lds + L_QH + sc * RS128 + sch * 16);
              *(v4u*)(obuf + (t0 + sc) * 1024 + 512 + h * 128 + sch * 16) = ov; }
        }
        HG_BAR();
    }
    if constexpr (!FULL) {
        float* Lo = Lbuf + (size_t)(ubase + seg) * 16384; float* Go = Gbuf + (ubase + seg) * 128;
#pragma unroll
        for (int r = 0; r < 4; ++r) {
#pragma unroll
            for (int ni = 0; ni < 8; ++ni) Lo[(dd0 + r) * 128 + 16 * ni + vl] = S[ni][r];
            if (vl == 0) Go[dd0 + r] = Gacc[r]; }
    }
}
}
struct EpiBranch {
    static constexpr int PERM = 1;
    const unsigned char* gates; unsigned char* merged;
    __device__ __forceinline__ void mid(f32x4 (&acc)[2][2][4][2], const pg8::Unit& u, int wr, int wc, int fr, int fq) const {
        const int row0 = u.pm * 256 + wr * 64 + fr, col0 = u.pn * 256 + wc * 32 + 8 * fq;
#pragma unroll
        for (int ai = 0; ai < 2; ++ai) {
            v2u g1[4][2], g2[4][2];
#pragma unroll
            for (int m = 0; m < 4; ++m)
#pragma unroll
                for (int bj = 0; bj < 2; ++bj) { const unsigned char* gp = gates + (size_t)(row0 + ai * 128 + m * 16) * NG + col0 + bj * 128; g1[m][bj] = *(const v2u*)gp; g2[m][bj] = *(const v2u*)(gp + 1024); }
#pragma unroll
            for (int m = 0; m < 4; ++m)
#pragma unroll
                for (int bj = 0; bj < 2; ++bj) { const unsigned a1x = g1[m][bj].x, a1y = g1[m][bj].y, a2x = g2[m][bj].x, a2y = g2[m][bj].y;
#define RHO(x1, x2) ((1.0f + __expf(-fmaxf(x2, -20.f))) * __builtin_amdgcn_rcpf(1.0f + __expf(-(x1))))
                    const auto p0 = __builtin_amdgcn_cvt_pk_f32_fp8((int)a1x, false), p1 = __builtin_amdgcn_cvt_pk_f32_fp8((int)a1x, true), p2 = __builtin_amdgcn_cvt_pk_f32_fp8((int)a1y, false), p3 = __builtin_amdgcn_cvt_pk_f32_fp8((int)a1y, true);
                    const auto q0 = __builtin_amdgcn_cvt_pk_f32_fp8((int)a2x, false), q1 = __builtin_amdgcn_cvt_pk_f32_fp8((int)a2x, true), q2 = __builtin_amdgcn_cvt_pk_f32_fp8((int)a2y, false), q3 = __builtin_amdgcn_cvt_pk_f32_fp8((int)a2y, true);
                    f32x4& v0 = acc[ai][bj][m][0]; f32x4& v1 = acc[ai][bj][m][1];
                    v0[0] *= RHO(p0[0], q0[0]); v0[1] *= RHO(p0[1], q0[1]); v0[2] *= RHO(p1[0], q1[0]); v0[3] *= RHO(p1[1], q1[1]);
                    v1[0] *= RHO(p2[0], q2[0]); v1[1] *= RHO(p2[1], q2[1]); v1[2] *= RHO(p3[0], q3[0]); v1[3] *= RHO(p3[1], q3[1]);
#undef RHO
                }
            asm volatile("" ::: "memory"); }
    }
    __device__ __forceinline__ void operator()(const f32x4 (&acc)[2][2][4][2], const pg8::Unit& u, int wr, int wc, int fr, int fq) const {
        const int row0 = u.pm * 256 + wr * 64 + fr, col0 = u.pn * 256 + wc * 32 + 8 * fq;
#pragma unroll
        for (int ai = 0; ai < 2; ++ai) {
            v2u g[4][2];
#pragma unroll
            for (int m = 0; m < 4; ++m)
#pragma unroll
                for (int bj = 0; bj < 2; ++bj) g[m][bj] = *(const v2u*)(gates + (size_t)(row0 + ai * 128 + m * 16) * NG + 1024 + col0 + bj * 128);
#pragma unroll
            for (int m = 0; m < 4; ++m)
#pragma unroll
                for (int bj = 0; bj < 2; ++bj) { const size_t row = (size_t)(row0 + ai * 128 + m * 16); const int c = col0 + bj * 128;
                    const f32x4 v0 = acc[ai][bj][m][0], v1 = acc[ai][bj][m][1]; const unsigned gx = g[m][bj].x, gy = g[m][bj].y;
                    const auto p0 = __builtin_amdgcn_cvt_pk_f32_fp8((int)gx, false), p1 = __builtin_amdgcn_cvt_pk_f32_fp8((int)gx, true), p2 = __builtin_amdgcn_cvt_pk_f32_fp8((int)gy, false), p3 = __builtin_amdgcn_cvt_pk_f32_fp8((int)gy, true);
#define SG(x) ((1.f / WBS_SCALE) * fsigmoid(fmaxf(x, -20.f)))
                    v2u w; w.x = pk4_fp8(SG(p0[0]) * v0[0], SG(p0[1]) * v0[1], SG(p1[0]) * v0[2], SG(p1[1]) * v0[3]);
                    w.y = pk4_fp8(SG(p2[0]) * v1[0], SG(p2[1]) * v1[1], SG(p3[0]) * v1[2], SG(p3[1]) * v1[3]);
#undef SG
                    *(v2u*)(merged + row * 1024 + c) = w; }
            asm volatile("" ::: "memory"); }
    }
};
struct EpiXmid {
    static constexpr int PERM = 1;
    const float* x; const float* mod; bf16* xmid;
    __device__ __forceinline__ void operator()(const f32x4 (&acc)[2][2][4][2], const pg8::Unit& u, int wr, int wc, int fr, int fq) const {
        const int row0 = u.pm * 256 + wr * 64 + fr, col0 = u.pn * 256 + wc * 32 + 8 * fq; const int b = (u.pm * 256) >> 12;
        f32x4 g1[2][2];
#pragma unroll
        for (int bj = 0; bj < 2; ++bj)
#pragma unroll
            for (int n = 0; n < 2; ++n) g1[bj][n] = *(const f32x4*)(mod + b * 6144 + 2048 + col0 + bj * 128 + n * 4) * (1.f / WO_SCALE);
#pragma unroll
        for (int ai = 0; ai < 2; ++ai)
#pragma unroll
            for (int m = 0; m < 4; ++m) { const size_t off = (size_t)(row0 + ai * 128 + m * 16) * 1024 + col0;
#pragma unroll
                for (int bj = 0; bj < 2; ++bj) { const f32x4 x0 = *(const f32x4*)(x + off + bj * 128), x1 = *(const f32x4*)(x + off + bj * 128 + 4);
                    const f32x4 y0 = x0 + g1[bj][0] * acc[ai][bj][m][0], y1 = x1 + g1[bj][1] * acc[ai][bj][m][1];
                    v4u w; w.x = pg8::cvt_pk_bf16(y0[0], y0[1]); w.y = pg8::cvt_pk_bf16(y0[2], y0[3]); w.z = pg8::cvt_pk_bf16(y1[0], y1[1]); w.w = pg8::cvt_pk_bf16(y1[2], y1[3]);
                    *(v4u*)(xmid + off + bj * 128) = w; } }
    }
};
namespace rt {
constexpr int HTS = 2064;
constexpr int L_HTH = 0, L_HTL = 33024, L_RED = 66048, L_ASG = 98816, L_CNTL = 107008, L_BASE = 107520, L_SC = 108032, L_LOG = 109056;
constexpr int LOGS = 65;
static_assert(L_LOG + 128 * LOGS * 4 <= LDSCTL_OFF, "router LDS map");
__device__ __forceinline__ void route_block(Frame& F, const Args& a, int blk, int shadow, const XcdBarrier& wbar, const bool wsplit) {
    const int tid = F.tid, lane = F.lane, w = F.wave;
    const float* mod = (const float*)(a.ws + WS_MOD); unsigned char* H2 = a.ws + WS_H2;
    LAS float* RED = (LAS float*)(F.lds + L_RED); LAS unsigned* ASG = (LAS unsigned*)(F.lds + L_ASG);
    LAS int* CNTL = (LAS int*)(F.lds + L_CNTL); LAS int* BASE = (LAS int*)(F.lds + L_BASE); LAS float* LOG = (LAS float*)(F.lds + L_LOG);
    const int tok0 = blk * 128; const int b = tok0 >> 12;
    const float bias = a.router_bias[fresh_lane()];
    LAS float* MA = (LAS float*)(F.lds + EPI_STG_OFF); LAS float* MB = MA + 1024;
    for (int c = tid; c < 1024; c += 512) { MA[c] = a.norm2_g[c] * (mod[b * 6144 + 4096 + c] + 1.0f); MB[c] = mod[b * 6144 + 3072 + c]; }
    if (tid < 64) ((LAS float*)(F.lds + L_SC))[tid] = a.router_bias[tid];
    __syncthreads();
    bf16x8 whi[4][4], wlo[4][4];
    {
      const v4u* WH = (const v4u*)(a.ws + WS_WRT) + (size_t)w * 16 * 64 + lane; const v4u* WL = WH + 8 * 16 * 64; asm volatile("" : "+v"(WH), "+v"(WL));
#pragma unroll
      for (int ks = 0; ks < 4; ++ks)
#pragma unroll
          for (int nb = 0; nb < 4; ++nb) { const v4u h = WH[(ks * 4 + nb) * 64], l = WL[(ks * 4 + nb) * 64];
              whi[ks][nb] = __builtin_bit_cast(bf16x8, h); wlo[ks][nb] = __builtin_bit_cast(bf16x8, l); } }
    asm volatile("" ::: "memory");
    if (wsplit) xcd_wait(wbar);
#define RT_BAR() do { asm volatile("s_waitcnt lgkmcnt(0)" ::: "memory"); __builtin_amdgcn_s_barrier(); asm volatile("" ::: "memory"); } while (0)
    v2u nx[2][4];
#pragma unroll
    for (int rr = 0; rr < 2; ++rr) { const GAS v2u* xp = (const GAS v2u*)((const bf16*)(a.ws + WS_XMID) + (size_t)(tok0 + 2 * w + rr) * D) + lane;
#pragma unroll
        for (int j = 0; j < 4; ++j) nx[rr][j] = xp[64 * j]; }
    for (int bt = 0; bt < 8; ++bt) {
        int lane_b = lane; asm volatile("" : "+v"(lane_b));
#pragma unroll
        for (int rr = 0; rr < 2; ++rr) {
            const int tl = 2 * w + rr, m = tok0 + 16 * bt + tl;
            f32x4 v[4]; float s2 = 0.f;
#pragma unroll
            for (int j = 0; j < 4; ++j) { const v2u xb = nx[rr][j]; v[j] = (f32x4){bflo(xb.x), bfhi(xb.x), bflo(xb.y), bfhi(xb.y)}; s2 += (v[j].x * v[j].x + v[j].y * v[j].y) + (v[j].z * v[j].z + v[j].w * v[j].w); }
            const float rstd = __builtin_amdgcn_rsqf(wave_sum(s2) * (1.f / D) + EPS);
            GAS unsigned* o8 = (GAS unsigned*)(H2 + (size_t)m * D) + lane_b;
#pragma unroll
            for (int j = 0; j < 4; ++j) { const int c0 = 4 * lane_b + 256 * j;
                const f32x4 ma = *(const LAS f32x4*)(MA + c0), mb = *(const LAS f32x4*)(MB + c0);
                const f32x4 y = v[j] * rstd * ma + mb;
                o8[64 * j] = pk4_fp8(y.x, y.y, y.z, y.w);
                { v2u h, l; h.x = pg8::cvt_pk_bf16(y.x, y.y); h.y = pg8::cvt_pk_bf16(y.z, y.w);
                  l.x = pg8::cvt_pk_bf16(y.x - bflo(h.x), y.y - bfhi(h.x)); l.y = pg8::cvt_pk_bf16(y.z - bflo(h.y), y.w - bfhi(h.y));
                  *(LAS v2u*)(F.lds + L_HTH + tl * HTS + c0 * 2) = h; *(LAS v2u*)(F.lds + L_HTL + tl * HTS + c0 * 2) = l; }
                asm volatile("" ::: "memory"); }
        }
        if (bt < 7) {
#pragma unroll
            for (int rr = 0; rr < 2; ++rr) { const GAS v2u* xp = (const GAS v2u*)((const bf16*)(a.ws + WS_XMID) + (size_t)(tok0 + 16 * (bt + 1) + 2 * w + rr) * D) + lane_b;
#pragma unroll
                for (int j = 0; j < 4; ++j) nx[rr][j] = xp[64 * j]; } }
        RT_BAR();
        {
            f32x4 acc[4];
#pragma unroll
            for (int nb = 0; nb < 4; ++nb) acc[nb] = (f32x4){0.f, 0.f, 0.f, 0.f};
            const int i = lane_b & 15, kq = lane_b >> 4;
#pragma unroll
            for (int ks = 0; ks < 4; ++ks) {
                const bf16x8 ah = *(const LAS bf16x8*)(F.lds + L_HTH + i * HTS + (128 * w + 32 * ks + 8 * kq) * 2);
                const bf16x8 al = *(const LAS bf16x8*)(F.lds + L_HTL + i * HTS + (128 * w + 32 * ks + 8 * kq) * 2);
#pragma unroll
                for (int nb = 0; nb < 4; ++nb) {
                    acc[nb] = __builtin_amdgcn_mfma_f32_16x16x32_bf16(al, whi[ks][nb], acc[nb], 0, 0, 0);
                    acc[nb] = __builtin_amdgcn_mfma_f32_16x16x32_bf16(ah, wlo[ks][nb], acc[nb], 0, 0, 0);
                    acc[nb] = __builtin_amdgcn_mfma_f32_16x16x32_bf16(ah, whi[ks][nb], acc[nb], 0, 0, 0); } }
#pragma unroll
            for (int nb = 0; nb < 4; ++nb)
#pragma unroll
                for (int r = 0; r < 4; ++r) RED[(w * 16 + 4 * kq + r) * 64 + 16 * nb + i] = acc[nb][r];
        }
        RT_BAR();
#pragma unroll
        for (int rr = 0; rr < 2; ++rr) { const int tl = 2 * w + rr; float logit = 0.f;
#pragma unroll
            for (int p = 0; p < 8; ++p) logit += RED[(p * 16 + tl) * 64 + lane_b];
            LOG[(16 * bt + tl) * LOGS + lane_b] = logit; }
    }
    RT_BAR();
    if (w < 2) {
        const int lane_t = fresh_lane(); const int tloc = 64 * w + lane_t;
        const LAS float* BL = (const LAS float*)(F.lds + L_SC);
        float c[64];
#pragma unroll
        for (int e = 0; e < 64; ++e) c[e] = fsigmoid(LOG[tloc * LOGS + e]) + BL[e];
        float gs[8];
#pragma unroll
        for (int g = 0; g < 8; ++g) { float m1 = -INFINITY, m2 = -INFINITY;
#pragma unroll
            for (int j = 0; j < 8; ++j) { const float x = c[8 * g + j]; m2 = fmaxf(m2, fminf(m1, x)); m1 = fmaxf(m1, x); }
            gs[g] = m1 + m2; }
        bool keep[8];
#pragma unroll
        for (int g = 0; g < 8; ++g) { int rk = 0;
#pragma unroll
            for (int j = 0; j < 8; ++j) { if (j < g) rk += (gs[j] >= gs[g]) ? 1 : 0; else if (j > g) rk += (gs[j] > gs[g]) ? 1 : 0; }
            keep[g] = rk < 4; }
        float v[8]; int ix[8];
#pragma unroll
        for (int k = 0; k < 8; ++k) { v[k] = -INFINITY; ix[k] = 0; }
#pragma unroll
        for (int e = 0; e < 64; ++e) { float x = keep[e >> 3] ? c[e] : -INFINITY; int xi = e;
#pragma unroll
            for (int k = 0; k < 8; ++k) { const bool gt = x > v[k]; const float tv = gt ? v[k] : x; const int ti = gt ? ix[k] : xi; v[k] = gt ? x : v[k]; ix[k] = gt ? xi : ix[k]; x = tv; xi = ti; } }
        float sc8[8], ssum = 0.f;
#pragma unroll
        for (int k = 0; k < 8; ++k) { sc8[k] = v[k] - BL[ix[k]]; ssum += sc8[k]; }
        const int tok = tok0 + tloc;
#pragma unroll
        for (int k = 0; k < 8; ++k) {
            ASG[(tloc * 8 + k) * 2] = (unsigned)tok | ((unsigned)k << 16) | ((unsigned)ix[k] << 19);
            ASG[(tloc * 8 + k) * 2 + 1] = __builtin_bit_cast(unsigned, sc8[k] / ssum * 2.5f); }
    }
    const int tz = fresh_tid(w);
    if (tz < 64) CNTL[tz] = 0;
    __syncthreads();
    unsigned w0[2], w1[2]; int rnk[2];
#pragma unroll
    for (int j = 0; j < 2; ++j) { const int idx = tz + 512 * j; w0[j] = ASG[idx * 2]; w1[j] = ASG[idx * 2 + 1]; rnk[j] = atomicAdd((int*)&CNTL[w0[j] >> 19], 1); }
    __syncthreads();
    { const int tq = fresh_tid(w);
      if (tq < 64) { const int c = CNTL[tq]; BASE[tq] = c ? (int)__hip_atomic_fetch_add((unsigned*)(F.ctl + (shadow ? 65536 : CW_CNT) + 64 * tq), (unsigned)c, RLX_AGENT) : 0; } }
    __syncthreads();
    v2u* lists = (v2u*)(a.ws + (shadow ? WS_ACT : WS_LIST));
#pragma unroll
    for (int j = 0; j < 2; ++j) { const int ve = w0[j] >> 19; lists[(size_t)ve * T + BASE[ve] + rnk[j]] = (v2u){w0[j] & 0x7FFFFu, w1[j]}; }
#if DBG_CHECK
    { v2u* dbg = (v2u*)(a.ws + WS_ACT);
#pragma unroll
      for (int j = 0; j < 2; ++j) { const int idx = tid + 512 * j; dbg[(size_t)tok0 * 8 + idx] = (v2u){w0[j], w1[j]}; } }
#endif
    __syncthreads();
}
}
namespace ex {
constexpr int MAXT = 5, EN_OFF = RING_BYTES;
static_assert(EN_OFF + MAXT * 2048 <= LDSCTL_OFF, "entry cache");
__device__ __forceinline__ void build_tables(Frame& F, const v2u* lists) {
    LAS int* TP = (LAS int*)(F.lds + TAB_OFF); LAS int* PS = TP + 66; LAS int* CN = PS + 66; LAS int* UT = TP + 256;
    if (F.tid == 0) {
        int cnt[65];
#pragma unroll
        for (int ve = 0; ve < 64; ++ve) cnt[ve] = (int)__hip_atomic_load(F.ctl + CW_CNT + 64 * ve, RLX_AGENT);
        cnt[64] = T;
        int tp = 0, ps = 0;
#pragma unroll
        for (int ve = 0; ve <= 64; ++ve) { TP[ve] = tp; PS[ve] = ve < 64 ? ps : ACT_SH0; CN[ve] = cnt[ve]; tp += (cnt[ve] + 255) >> 8; ps += ((cnt[ve] + 255) >> 8) << 8; }
        TP[65] = tp;
    }
    __syncthreads();
    if (F.tid < 8) {
        const int L = F.tid * F.G + F.vcu; int ve = -1, r0 = 0, nr = 0, ar = 0;
        if (L < TP[65]) { int lo = 0, hi = 64; while (lo < hi) { const int mid = (lo + hi + 1) >> 1; if (TP[mid] <= L) lo = mid; else hi = mid - 1; }
            ve = lo; r0 = (L - TP[lo]) << 8; const int rem = CN[lo] - r0; nr = rem < 256 ? rem : 256; ar = PS[lo] + r0; }
        UT[F.tid * 4] = ve; UT[F.tid * 4 + 1] = r0; UT[F.tid * 4 + 2] = nr; UT[F.tid * 4 + 3] = ar;
    }
    __syncthreads();
    LAS v2u* EN = (LAS v2u*)(F.lds + EN_OFF);
    for (int e = F.tid; e < MAXT * 256; e += 512) { const int j = e >> 8, r = e & 255; const int ve = UT[j * 4], r0 = UT[j * 4 + 1], nr = UT[j * 4 + 2];
        v2u en = (v2u){0u, 0u};
        if (ve == 64) en = (v2u){(unsigned)(r0 + (r < nr ? r : 0)) | (8u << 16), 0x3f800000u};
        else if (ve >= 0 && r < nr) en = lists[(size_t)ve * T + r0 + r];
        EN[e] = en; }
    __syncthreads();
}
__device__ __forceinline__ bool unit_tile(const LAS int* UT, int j, pg8::Unit& u) {
    if (j >= MAXT) return false;
    const int ve = __builtin_amdgcn_readfirstlane(UT[j * 4]); if (ve < 0) return false;
    u.z = ve; u.r0 = __builtin_amdgcn_readfirstlane(UT[j * 4 + 1]); u.nr = __builtin_amdgcn_readfirstlane(UT[j * 4 + 2]); u.ar = __builtin_amdgcn_readfirstlane(UT[j * 4 + 3]); u.pm = j;
    return true;
}
struct SchedGU {
    const LAS int* UT; const LAS v2u* EN; const char* H2; const char* Wgu; int lda, ldb;
    __device__ __forceinline__ bool next(int i, pg8::Unit& u) const { if (!unit_tile(UT, i >> 1, u)) return false; u.pn = i & 1; return true; }
    __device__ __forceinline__ const char* a_base(const pg8::Unit&) const { return H2; }
    __device__ __forceinline__ const char* b_base(const pg8::Unit& u) const { const int e = u.z; return Wgu + ((size_t)e * 512 + u.pn * 256) * 1024; }
    __device__ __forceinline__ unsigned a_row(const pg8::Unit& u, int R) const {
        return EN[u.pm * 256 + R].x & 0xFFFFu;
    }
};
using ::pk4_fp8;
struct EpiAct {
    static constexpr int PERM = 1;
    unsigned char* act;
    __device__ __forceinline__ void operator()(const f32x4 (&acc)[2][2][4][2], const pg8::Unit& u, int wr, int wc, int fr, int fq) const {
        const int hc0 = u.pn * 128 + wc * 32 + 8 * fq;
#pragma unroll
        for (int ai = 0; ai < 2; ++ai)
#pragma unroll
            for (int m = 0; m < 4; ++m) { const int rloc = ai * 128 + wr * 64 + m * 16 + fr;
#define SWG(g, u) (((g) * (u)) * (ACT_SCALE / (WGU_SCALE * WGU_SCALE)) * __builtin_amdgcn_rcpf(1.0f + __builtin_amdgcn_exp2f((g) * (-1.44269504f / WGU_SCALE))))
                const f32x4 g0 = acc[ai][0][m][0], g1 = acc[ai][0][m][1], u0 = acc[ai][1][m][0], u1 = acc[ai][1][m][1];
                v2u w; w.x = pk4_fp8(SWG(g0[0], u0[0]), SWG(g0[1], u0[1]), SWG(g0[2], u0[2]), SWG(g0[3], u0[3]));
                w.y = pk4_fp8(SWG(g1[0], u1[0]), SWG(g1[1], u1[1]), SWG(g1[2], u1[2]), SWG(g1[3], u1[3]));
#undef SWG
                *(v2u*)(act + (size_t)(u.ar + rloc) * EH + hc0) = w; asm volatile("" ::: "memory"); }
    }
};
struct SchedDown {
    const LAS int* UT; const char* Act; const char* Wd; int lda, ldb;
    __device__ __forceinline__ bool next(int i, pg8::Unit& u) const { if (!unit_tile(UT, i >> 2, u)) return false; u.pn = i & 3; return true; }
    __device__ __forceinline__ const char* a_base(const pg8::Unit& u) const { return Act + (size_t)u.ar * EH; }
    __device__ __forceinline__ const char* b_base(const pg8::Unit& u) const { const int e = u.z; return Wd + ((size_t)e * 1024 + u.pn * 256) * EH; }
    __device__ __forceinline__ unsigned a_row(const pg8::Unit&, int) const { return 0u; }
};
__device__ __forceinline__ unsigned char* y_row(unsigned char* ws, int tok, int slot) {
    if (slot == 8) return ws + (tok < 16384 ? WS_YS0 : WS_YS1) + (size_t)(tok & 16383) * 1024;
    const int q = tok >> 13; const size_t base = q == 0 ? WS_Y0 : (q == 1 ? WS_Y1 : (q == 2 ? WS_Y2 : WS_Y3));
    return ws + base + ((size_t)(tok & 8191) * 8 + slot) * 1024;
}
__device__ __forceinline__ void en_to_yrows(Frame& F, unsigned char* ws) {
    const LAS int* UT = (const LAS int*)(F.lds + TAB_OFF) + 256; LAS v2u* EN = (LAS v2u*)(F.lds + EN_OFF);
    for (int e = F.tid; e < MAXT * 256; e += 512) { const int j = e >> 8, r = e & 255; const int ve = UT[j * 4], nr = UT[j * 4 + 2];
        const unsigned ex = EN[e].x; const int tok = ex & 0xFFFFu, slot = (ex >> 16) & 15;
        const size_t off = (ve >= 0 && r < nr) ? (size_t)(y_row(ws, tok, slot) - ws) : WS_DUMP;
        EN[e].x = (unsigned)(off >> 10); }
    __syncthreads();
}
__device__ __forceinline__ unsigned pk4_fp8_nc(float a, float b, float c, float d) { int r = __builtin_amdgcn_cvt_pk_fp8_f32(a, b, 0, false); r = __builtin_amdgcn_cvt_pk_fp8_f32(c, d, r, true); return (unsigned)r; }
struct EpiDown {
    static constexpr int PERM = 2;
    unsigned char* ws; const LAS v2u* EN; int shadow;
    __device__ __forceinline__ void operator()(const f32x4 (&acc)[2][2][4][2], const pg8::Unit& u, int wr, int wc, int fr, int fq) const {
        const int col0 = u.pn * 256 + wc * 64 + 16 * fq;
        v2u en[2][4];
#pragma unroll
        for (int ai = 0; ai < 2; ++ai)
#pragma unroll
            for (int m = 0; m < 4; ++m) { const int rloc = ai * 128 + wr * 64 + m * 16 + fr; en[ai][m] = EN[u.pm * 256 + rloc]; }
#pragma unroll
        for (int ai = 0; ai < 2; ++ai)
#pragma unroll
            for (int m = 0; m < 4; ++m) {
                const unsigned yo = en[ai][m].x, ey = en[ai][m].y; const float wgt = __uint_as_float(ey) * (Y_SCALE / (ACT_SCALE * WD_SCALE));
                const f32x4 v0 = acc[ai][0][m][0] * wgt, v1 = acc[ai][0][m][1] * wgt, v2 = acc[ai][1][m][0] * wgt, v3 = acc[ai][1][m][1] * wgt;
                v4u w; w.x = pk4_fp8_nc(v0[0], v0[1], v0[2], v0[3]); w.y = pk4_fp8_nc(v1[0], v1[1], v1[2], v1[3]); w.z = pk4_fp8_nc(v2[0], v2[1], v2[2], v2[3]); w.w = pk4_fp8_nc(v3[0], v3[1], v3[2], v3[3]);
                __builtin_nontemporal_store(w, (v4u*)(ws + (size_t)yo * 1024 + col0)); }
    }
};
__device__ __forceinline__ void combine(Frame& F, const Args& a, float* out_w) {
    const float* mod = (const float*)(a.ws + WS_MOD);
    const int gw = F.vcu * 8 + F.wave, NGW = F.G * 8;
    for (int tok = gw; tok < T; tok += NGW) {
        const int b = tok >> 12; const GAS v2u* op = (const GAS v2u*)((const bf16*)(a.ws + WS_XMID) + (size_t)tok * D) + F.lane; GAS f32x4* ow = (GAS f32x4*)(out_w + (size_t)tok * D) + F.lane;
        const unsigned char* y0 = ex::y_row(a.ws, tok, 0); const unsigned char* ysh = ex::y_row(a.ws, tok, 8);
#pragma unroll
        for (int j = 0; j < 4; ++j) { const int c0 = 4 * F.lane + 256 * j; f32x4 s = (f32x4){0.f, 0.f, 0.f, 0.f};
#pragma unroll
            for (int sl = 0; sl < 9; ++sl) { const int p = *(const int*)((sl < 8 ? y0 + sl * 1024 : ysh) + c0); const auto lo = __builtin_amdgcn_cvt_pk_f32_fp8(p, false), hi = __builtin_amdgcn_cvt_pk_f32_fp8(p, true); s += (f32x4){lo[0], lo[1], hi[0], hi[1]}; }
            const f32x4 g2 = *(const f32x4*)(mod + b * 6144 + 5120 + c0) * (1.f / Y_SCALE);
            const v2u xb = op[64 * j];
            ow[64 * j] = (f32x4){bflo(xb.x), bfhi(xb.x), bflo(xb.y), bfhi(xb.y)} + g2 * s; }
    }
}
}
constexpr int NPHASE = 11;
__global__ void __launch_bounds__(512, 2) mk_fwd(Args a) {
    extern __shared__ __attribute__((aligned(16))) unsigned char lds[];
    Frame F;
    F.lds = (LAS unsigned char*)lds;
    F.MISC = (volatile LAS unsigned*)(F.lds + MISC_OFF);
    const int WV = __builtin_amdgcn_readfirstlane((int)threadIdx.x >> 6);
    F.tid = fresh_tid(WV); F.lane = F.tid & 63; F.wave = WV;
    F.G = gridDim.x; { const int bx = blockIdx.x; F.vcu = (F.G % 8 == 0) ? (bx % 8) * (F.G / 8) + bx / 8 : bx; }
    F.ctl = (gu32*)(a.ws + WS_CTL);
    for (int u = F.tid; u < (LDS_BYTES - LDSCTL_OFF) / 4; u += 512) ((LAS unsigned*)(F.lds + LDSCTL_OFF))[u] = 0u;
    __syncthreads();
    const int lo = a.ph_lo, hi = a.ph_hi;
    const bool multi = (hi - lo) > 1;
    XcdBarrier bar; bar.bar = (unsigned*)(F.ctl + CW_BAR); bar.x = 0; bar.st = nullptr; bar.wv = WV;
    if (multi) bar = xcd_barrier_post((unsigned*)(F.ctl + CW_BAR), F.MISC + 8, WV);
#ifndef PHASE_MASK
#define PHASE_MASK 0xFFF
#endif
#define IN(k) (((PHASE_MASK >> (k)) & 1) && lo <= (k) && (k) < hi)
#define GRID_BAR(k) do { if (IN((k) + 1)) xcd_barrier(bar); } while (0)
#ifndef REPEAT_MASK
#define REPEAT_MASK 0
#endif
#define REP(k) for (int rep_ = 0; rep_ <= ((REPEAT_MASK >> (k)) & 1); ++rep_)
#define REP_BAR(k) do { if (rep_ < ((REPEAT_MASK >> (k)) & 1) && multi) xcd_barrier(bar); } while (0)
#ifndef NO_DESYNC
#define DESYNC(n, s) do { const int g_ = (int)((blockIdx.x >> 3) & 3) * (n); for (int d_ = 0; d_ < g_; ++d_) __builtin_amdgcn_s_sleep(s); } while (0)
#else
#define DESYNC(n, s) do { } while (0)
#endif
#define FRESH() do { const int t_ = fresh_tid(WV); F.tid = t_; F.lane = t_ & 63; F.wave = WV; } while (0)

    const bool splitall = (REPEAT_MASK == 0) && (PHASE_MASK == 0xFFF) && multi && lo == 0 && hi >= NPHASE;
#define split0 splitall
#define split1 splitall
#define split2 splitall
#define split45 splitall
#define split6 splitall
    if (IN(0)) { REP(0) { FRESH(); p0a_mod(F, a); REP_BAR(0); } if (split0) xcd_arrive(bar); else GRID_BAR(0); }
    const int cew_a = split1 ? 1 : 0, cew_b = split2 ? cew_a + 2 : cew_a;
    const int cew_c = split45 ? 10 : -1;
    if (IN(1)) { REP(1) { FRESH(); p0b_prologue(F, a, bar, split0); REP_BAR(1); }
        if (split1) { xcd_arrive(bar); convert_expert_weights(F, a, F.lds + 69632, 0, cew_a); xcd_wait(bar); } else GRID_BAR(1); }
    if (IN(2)) REP(2) {
        SchedDense S; S.O.init(T, NIN, F.G, (int)blockIdx.x); S.A = (const char*)a.out + 64 * MiB; S.B = (const char*)(a.ws + WS_WIN); S.lda = D / 2; S.ldb = D / 2;
        EpiProj E{(bf16*)(a.ws + WS_PROJ), a.ws + WS_GATES, F.lds + EPI_STG_OFF, (int)(rep_ < ((REPEAT_MASK >> 2) & 1))};
#ifdef DESYNC_HALF
        if ((blockIdx.x >> 3) & 1) { __builtin_amdgcn_s_sleep(125); __builtin_amdgcn_s_sleep(125); }
#endif
        pg8::gemm_phase<EpiProj, SchedDense, false, 512, 512, 512, false, true>(F.lds, S, E, WV);
        REP_BAR(2);
        if (split2) { xcd_arrive(bar); convert_expert_weights(F, a, F.lds + 69632, cew_a, cew_b); xcd_wait(bar); }
        else if (rep_ == ((REPEAT_MASK >> 2) & 1)) GRID_BAR(2);
    }
    if (IN(3)) REP(3) {
        FRESH();
        const bool split = splitall;
        if (split) { for (int u = F.vcu; u < 256; u += F.G) hg::segment<false>(a, u >> 5, (u >> 3) & 3, u & 7, F.lds, WV); xcd_arrive(bar); }
        if (rep_ == 0 && (blockIdx.x & 1)) { __syncthreads(); convert_expert_weights(F, a, F.lds + 69632, cew_b, cew_c); __syncthreads(); }
        for (int u = F.vcu; u < 1024; u += F.G) sba::attn_unit(a, u >> 7, (u >> 4) & 7, (u & 15) ^ (5 * (u >> 8)), F.lds, WV);
        if (rep_ == 0 && !(blockIdx.x & 1)) { __syncthreads(); convert_expert_weights(F, a, F.lds + 69632, cew_b, cew_c); __syncthreads(); }
        __syncthreads();
        if (split) xcd_wait(bar);
        else { for (int u = F.vcu; u < 256; u += F.G) hg::segment<false>(a, u >> 5, (u >> 3) & 3, u & 7, F.lds, WV);
        REP_BAR(3); if (rep_ == ((REPEAT_MASK >> 3) & 1)) GRID_BAR(3); }
    }
    if (IN(4)) REP(4) {
#ifdef HG_ABL
        if (rep_) { for (int u = blockIdx.x; u < 256; u += F.G) hg::segment<true, HG_ABL>(a, u >> 5, (u >> 3) & 3, u & 7, F.lds, WV); } else
#endif
        for (int u = F.vcu; u < 256; u += F.G) hg::segment<true>(a, u >> 5, (u >> 3) & 3, u & 7, F.lds, WV);
        REP_BAR(4); if (split45) { xcd_arrive(bar); convert_expert_weights(F, a, F.lds + 69632, 10, 11); xcd_wait(bar); } else if (rep_ == ((REPEAT_MASK >> 4) & 1)) GRID_BAR(4);
    }
    if (IN(5)) REP(5) {
        SchedDense S; S.O.init(T, D, F.G, (int)blockIdx.x); S.A = (const char*)a.out; S.B = (const char*)(a.ws + WS_WBS); S.lda = D / 2; S.ldb = D / 2;
        EpiBranch E{a.ws + WS_GATES, a.ws + WS_MERGED};
        pg8::gemm_phase<EpiBranch, SchedDense, false, 512, 512, 512, true, true>(F.lds, S, E, WV);
        REP_BAR(5); if (split45) { xcd_arrive(bar); convert_expert_weights(F, a, F.lds + 69632, 11, 12); xcd_wait(bar); } else if (rep_ == ((REPEAT_MASK >> 5) & 1)) GRID_BAR(5);
    }
    if (IN(6)) REP(6) {
        SchedDense S; S.O.init(T, D, F.G, (int)blockIdx.x); S.A = (const char*)(a.ws + WS_MERGED); S.B = (const char*)(a.ws + WS_WO); S.lda = D / 2; S.ldb = D / 2;
        EpiXmid E{a.x, (const float*)(a.ws + WS_MOD), (bf16*)(a.ws + WS_XMID)};
        pg8::gemm_phase<EpiXmid, SchedDense, false, 512, 512, 512, false, true>(F.lds, S, E, WV);
        REP_BAR(6); if (split6) { xcd_arrive(bar); if (split45) { convert_expert_weights(F, a, F.lds + 69632, 12, -1); __syncthreads(); } } else if (rep_ == ((REPEAT_MASK >> 6) & 1)) GRID_BAR(6);
    }
    if (IN(7)) REP(7) {
        FRESH();
        bool towait = split6;
        for (int blk = blockIdx.x; blk < T / 128; blk += F.G) { rt::route_block(F, a, blk, rep_, bar, towait); towait = false; }
        if (towait) xcd_wait(bar);
        REP_BAR(7); if (rep_ == ((REPEAT_MASK >> 7) & 1)) GRID_BAR(7);
    }
    if (IN(8)) REP(8) {
        FRESH(); __syncthreads(); ex::build_tables(F, (const v2u*)(a.ws + WS_LIST));
        ex::SchedGU S; S.UT = (const LAS int*)(F.lds + TAB_OFF) + 256; S.EN = (const LAS v2u*)(F.lds + ex::EN_OFF);
        S.H2 = (const char*)(a.ws + WS_H2); S.Wgu = (const char*)(a.ws + WS_WGU); S.lda = D / 2; S.ldb = D / 2;
        ex::EpiAct E{a.ws + WS_ACT};
        pg8::gemm_phase<ex::EpiAct, ex::SchedGU, true, 512, 512, 512, false, true>(F.lds, S, E, WV);
        REP_BAR(8); if (rep_ == ((REPEAT_MASK >> 8) & 1)) GRID_BAR(8);
    }
    if (IN(9)) REP(9) {
        FRESH(); __syncthreads();
        if (rep_ == 0 && !IN(8)) ex::build_tables(F, (const v2u*)(a.ws + WS_LIST));
        if (rep_ == 0) ex::en_to_yrows(F, a.ws);
        ex::SchedDown S; S.UT = (const LAS int*)(F.lds + TAB_OFF) + 256;
        S.Act = (const char*)(a.ws + WS_ACT); S.Wd = (const char*)(a.ws + WS_WD); S.lda = EH / 2; S.ldb = EH / 2;
        ex::EpiDown E{a.ws, (const LAS v2u*)(F.lds + ex::EN_OFF), rep_};
        pg8::gemm_phase<ex::EpiDown, ex::SchedDown, false, 128, 128, 128, false, true>(F.lds, S, E, WV);
        REP_BAR(9); if (rep_ == ((REPEAT_MASK >> 9) & 1)) GRID_BAR(9);
    }
    if (IN(10)) REP(10) { FRESH(); ex::combine(F, a, rep_ ? (float*)(a.ws + WS_ACT) : a.out); REP_BAR(10); }
#undef IN
#undef GRID_BAR
}

#if DBG_CHECK
__global__ void k_signature(Args a) {
    const unsigned w = *(const unsigned*)(a.ws + WS_CTL + 4 * CW_FAIL);
    if (!w) return;
    const float code = (float)(100 - (int)w);
    size_t i = (size_t)blockIdx.x * blockDim.x + threadIdx.x;
    for (; i < (size_t)T * D; i += (size_t)gridDim.x * blockDim.x) a.out[i] = -code * a.x[i];
}
#endif

extern "C" void kernel_launch(void* const* d_in, const int* in_sizes, int n_in, void* d_out, int out_size, void* d_ws, size_t ws_size, hipStream_t stream) {
    static int grid = 0;
    if (grid == 0) {
        if (n_in != 22 || out_size != T * D || ws_size < WS_END) { fprintf(stderr, "kernel_launch: unexpected shapes (n_in %d out %d ws %zu)\n", n_in, out_size, ws_size); grid = -1; return; }
        int dev = 0, cus = 0, per_cu = 0;
        if (hipGetDevice(&dev) != hipSuccess || hipDeviceGetAttribute(&cus, hipDeviceAttributeMultiprocessorCount, dev) != hipSuccess) { grid = -1; return; }
        if (hipFuncSetAttribute((const void*)mk_fwd, hipFuncAttributeMaxDynamicSharedMemorySize, LDS_BYTES) != hipSuccess) { fprintf(stderr, "kernel_launch: hipFuncSetAttribute failed\n"); grid = -1; return; }
        if (hipOccupancyMaxActiveBlocksPerMultiprocessor(&per_cu, (const void*)mk_fwd, 512, LDS_BYTES) != hipSuccess || per_cu < 1) fprintf(stderr, "kernel_launch: occupancy query reports %d\n", per_cu);
        (void)hipGetLastError();
        grid = cus;
    }
    if (grid < 0) return;
    (void)hipMemsetAsync((char*)d_ws + WS_CTL, 0, CTL_ZERO_BYTES, stream);
    Args a{};
    const float** p = (const float**)&a;
    for (int i = 0; i < 22; ++i) p[i] = (const float*)d_in[i];
    a.out = (float*)d_out; a.ws = (unsigned char*)d_ws;
#if MK_N_LAUNCHES == 1
    a.ph_lo = 0; a.ph_hi = NPHASE;
    hipLaunchKernelGGL(mk_fwd, dim3(grid), dim3(512), LDS_BYTES, stream, a);
#else
    for (int ph = 0; ph < NPHASE; ++ph) {
        a.ph_lo = ph; a.ph_hi = ph + 1;
        hipLaunchKernelGGL(mk_fwd, dim3(grid), dim3(512), LDS_BYTES, stream, a);
#if DBG_CHECK
        unsigned* ctl = (unsigned*)((char*)d_ws + WS_CTL); unsigned char* ws = (unsigned char*)d_ws;
        if (ph == 0) chk_mod<<<8, 256, 0, stream>>>(a, 1);
        if (ph == 1) {
            chk_wt<<<32, 256, 0, stream>>>(a.w_in, D, NIN, (const bf16*)(ws + WS_WIN), 0, 0, ctl, 2);
            chk_wt<<<8, 256, 0, stream>>>(a.w_br_sb, 512, D, (const bf16*)(ws + WS_WBS), 0, 0, ctl, 2);
            chk_wt<<<8, 256, 0, stream>>>(a.w_br_hg, 512, D, (const bf16*)(ws + WS_WBH), 0, 0, ctl, 2);
            chk_wt<<<8, 256, 0, stream>>>(a.w_out, D, D, (const bf16*)(ws + WS_WO), 0, 0, ctl, 2);
            for (int e = 0; e < 65; e += 9) {
                const float* wg = e < 64 ? a.w_e_gate + (size_t)e * D * EH : a.w_s_gate; const float* wu = e < 64 ? a.w_e_up + (size_t)e * D * EH : a.w_s_up; const float* wd = e < 64 ? a.w_e_down + (size_t)e * EH * D : a.w_s_down;
                chk_wt<<<8, 256, 0, stream>>>(wg, D, EH, (const bf16*)(ws + WS_WGU) + (size_t)e * 512 * D, 1, 0, ctl, 3);
                chk_wt<<<8, 256, 0, stream>>>(wu, D, EH, (const bf16*)(ws + WS_WGU) + (size_t)e * 512 * D, 1, 1, ctl, 3);
                chk_wt<<<8, 256, 0, stream>>>(wd, EH, D, (const bf16*)(ws + WS_WD) + (size_t)e * D * EH, 0, 0, ctl, 3);
            }
            chk_h<<<16, 256, 0, stream>>>(a, 4);
        }
        if (ph == 2) {
            chk_gemm_bf16<<<64, 256, 0, stream>>>((const bf16*)((char*)d_out + 64 * MiB), D, (const bf16*)(ws + WS_WIN), D, T, NA, D, (const bf16*)(ws + WS_PROJ), NA, 0, 0, ctl, 5);
            chk_gemm_bf16<<<64, 256, 0, stream>>>((const bf16*)((char*)d_out + 64 * MiB), D, (const bf16*)(ws + WS_WIN), D, T, NG, D, (const bf16*)(ws + WS_GATES), NG, 0, NA, ctl, 6);
        }
        if (ph == 4) {
            chk_attn<<<(1024 + 256) / 4, 256, 0, stream>>>(a, 7);
            chk_hgrn<<<4, 512, 0, stream>>>(a, 8, 1100);
        }
        if (ph == 5) chk_merged<<<32, 256, 0, stream>>>(a, 9);
        if (ph == 6) chk_xmid<<<32, 256, 0, stream>>>(a, 10);
        if (ph == 6) dbg_copy_xmid<<<128, 256, 0, stream>>>(a);
        if (ph == 7) { chk_route<<<16, 64, 0, stream>>>(a, 11); chk_route_fin<<<1, 64, 0, stream>>>(ctl, 11); dbg_copy_asg<<<128, 64, 0, stream>>>(a); chk_wsum<<<1, 128, 0, stream>>>(a, 15); }
        if (ph == 10) chk_final<<<128, 64, 0, stream>>>(a, 20);
        if (ph == 8) chk_act<<<32, 256, 0, stream>>>(a, 19);
#endif
    }
#endif
#if DBG_CHECK == 1
    k_signature<<<2048, 256, 0, stream>>>(a);
#endif
}
```
